# Optimizing an MI355X kernel written in HIP

```python
import jax, jax.numpy as jnp
from jax import lax
import numpy as np

D_MODEL = 1024
BATCH = 4
SEQ = 4096
DEPTH = 1

D_PLE = 256
HEAD_DIM = 64
RET_WIDTH = D_MODEL // 2
RWKV_WIDTH = D_MODEL - RET_WIDTH
RET_HEADS = RET_WIDTH // HEAD_DIM
RWKV_HEADS = RWKV_WIDTH // HEAD_DIM
MIX_WIDTH = RET_WIDTH + RWKV_WIDTH
RET_CHUNK = 128
ROPE_BASE = 10000.0
DECAY_LORA = 64
AAA_LORA = 64
GATE_LORA = 160
D_FF = 2816
LN_EPS = 1e-5
RET_GN_EPS = 1e-5
RWKV_GN_EPS = 64e-5
DEEPNORM_ALPHA = (2.0 * DEPTH) ** 0.25
DEEPNORM_BETA = (8.0 * DEPTH) ** -0.25

RET_COLS = 4 * RET_WIDTH
RW_COLS = 3 * RWKV_WIDTH + DECAY_LORA + AAA_LORA + GATE_LORA
IN_COLS = RET_COLS + RW_COLS
RW_SPLITS = (RWKV_WIDTH, 2 * RWKV_WIDTH, 3 * RWKV_WIDTH,
             3 * RWKV_WIDTH + DECAY_LORA, 3 * RWKV_WIDTH + DECAY_LORA + AAA_LORA)

kernel_name = 'hymba_retnet_rwkv7_macaron_deepnorm'


def _layer_norm(x, g, b):
    xf = x.astype(jnp.float32)
    mu = jnp.mean(xf, axis=-1, keepdims=True)
    var = jnp.mean(jnp.square(xf - mu), axis=-1, keepdims=True)
    y = (xf - mu) * lax.rsqrt(var + LN_EPS) * g.astype(jnp.float32) + b.astype(jnp.float32)
    return y.astype(x.dtype)


def _head_group_norm(y, g, b, eps):
    mu = jnp.mean(y, axis=-1, keepdims=True)
    var = jnp.mean(jnp.square(y - mu), axis=-1, keepdims=True)
    bsz, s, h, d = y.shape
    yn = ((y - mu) * lax.rsqrt(var + eps)).reshape(bsz, s, h * d)
    return yn * g.astype(jnp.float32) + b.astype(jnp.float32)


def _swiglu(x, w_gu, w_down):
    hdn = jnp.einsum('bsd,df->bsf', x, w_gu)
    gate, up = jnp.split(hdn, 2, axis=-1)
    return jnp.einsum('bsf,fd->bsd', jax.nn.silu(gate) * up, w_down)


def _rotary(t):
    s, d = t.shape[1], t.shape[-1]
    pos = jnp.arange(s, dtype=jnp.float32)
    inv_freq = ROPE_BASE ** (-jnp.arange(0, d, 2, dtype=jnp.float32) / d)
    ang = pos[:, None] * inv_freq[None, :]
    cos = jnp.cos(ang)[None, :, None, :]
    sin = jnp.sin(ang)[None, :, None, :]
    t1, t2 = jnp.split(t, 2, axis=-1)
    return jnp.concatenate([t1 * cos - t2 * sin, t1 * sin + t2 * cos], axis=-1)


def _retention_chunkwise(q, k, v):
    bsz, s, h, dk = q.shape
    dv = v.shape[-1]
    c = RET_CHUNK
    n = s // c
    log_gamma = jnp.log1p(-jnp.exp2(-5.0 - jnp.arange(h, dtype=jnp.float32)))
    idx = jnp.arange(c, dtype=jnp.float32)
    rel = idx[:, None] - idx[None, :]
    causal = rel >= 0
    intra = jnp.where(causal[None], jnp.exp(jnp.where(causal, rel, 0.0)[None] * log_gamma[:, None, None]), 0.0)
    q_decay = jnp.exp((idx[None, :] + 1.0) * log_gamma[:, None])
    k_decay = jnp.exp((c - 1.0 - idx[None, :]) * log_gamma[:, None])
    chunk_decay = jnp.exp(c * log_gamma)
    qc = q.reshape(bsz, n, c, h, dk)
    kc = k.reshape(bsz, n, c, h, dk)
    vc = v.reshape(bsz, n, c, h, dv)
    scores = jnp.einsum('bnihd,bnjhd->bnhij', qc, kc) * intra
    inner = jnp.einsum('bnhij,bnjhe->bnihe', scores, vc)
    kv = jnp.einsum('bnjhd,bnjhe,hj->nbhde', kc, vc, k_decay)

    def step(state, kv_n):
        return chunk_decay[None, :, None, None] * state + kv_n, state

    _, prev_states = lax.scan(step, jnp.zeros((bsz, h, dk, dv), jnp.float32), kv)
    cross = jnp.einsum('bnihd,nbhde,hi->bnihe', qc, prev_states, q_decay)
    return (inner + cross).reshape(bsz, s, h, dv)


def _rwkv7_scan(r, w, k, v, kk, a):
    bsz, s, h, nd = r.shape
    b_vec = kk * a
    xs = tuple(jnp.moveaxis(t, 1, 0) for t in (r, w, k, v, kk, b_vec))

    def step(state, inp):
        r_t, w_t, k_t, v_t, kk_t, b_t = inp
        sa = jnp.einsum('bhvk,bhk->bhv', state, kk_t)
        state = (state * w_t[:, :, None, :] - sa[..., None] * b_t[:, :, None, :]
                 + v_t[..., None] * k_t[:, :, None, :])
        return state, jnp.einsum('bhvk,bhk->bhv', state, r_t)

    _, y = lax.scan(step, jnp.zeros((bsz, h, nd, nd), jnp.float32), xs)
    return jnp.moveaxis(y, 0, 1)


def _token_mixer(hin, w_in, ret_gn_g, ret_gn_b, rw_mu, rw_w0, rw_w_up, rw_a0, rw_a_up,
                 rw_g_up, rw_k_k, rw_k_a, rw_r_k, rw_gn_g, rw_gn_b, w_out):
    bsz, s, _ = hin.shape
    z = jnp.einsum('bsd,dc->bsc', hin, w_in).astype(jnp.float32)
    z_ret, z_rw = z[..., :RET_COLS], z[..., RET_COLS:]

    q, k, v, g = jnp.split(z_ret, 4, axis=-1)
    q = _rotary(q.reshape(bsz, s, RET_HEADS, HEAD_DIM))
    k = _rotary(k.reshape(bsz, s, RET_HEADS, HEAD_DIM)) * (HEAD_DIM ** -0.5)
    v = v.reshape(bsz, s, RET_HEADS, HEAD_DIM)
    ret = _retention_chunkwise(q, k, v)
    ret_out = jax.nn.silu(g) * _head_group_norm(ret, ret_gn_g, ret_gn_b, RET_GN_EPS)

    z_prev = jnp.pad(z_rw, ((0, 0), (1, 0), (0, 0)))[:, :-1]
    z_rw = z_rw + (z_prev - z_rw) * rw_mu.astype(jnp.float32)
    r, kr, vr, wd, ad, gd = jnp.split(z_rw, RW_SPLITS, axis=-1)
    w_log = -jax.nn.softplus(-(rw_w0 + jnp.tanh(wd) @ rw_w_up)) - 0.5
    decay = jnp.exp(-jnp.exp(w_log))
    a = jax.nn.sigmoid(rw_a0 + ad @ rw_a_up)
    gate = jax.nn.sigmoid(gd) @ rw_g_up
    heads = (bsz, s, RWKV_HEADS, HEAD_DIM)
    kk = (kr * rw_k_k).reshape(heads)
    kk = kk / jnp.maximum(jnp.sqrt(jnp.sum(jnp.square(kk), axis=-1, keepdims=True)), 1e-12)
    kr = kr * (1.0 + (a - 1.0) * rw_k_a)
    r_h, k_h, v_h = r.reshape(heads), kr.reshape(heads), vr.reshape(heads)
    y = _rwkv7_scan(r_h, decay.reshape(heads), k_h, v_h, kk, a.reshape(heads))
    bonus = jnp.sum(r_h * k_h * rw_r_k.astype(jnp.float32), axis=-1, keepdims=True) * v_h
    rw_out = (_head_group_norm(y, rw_gn_g, rw_gn_b, RWKV_GN_EPS) + bonus.reshape(bsz, s, RWKV_WIDTH)) * gate

    mixed = jnp.concatenate([ret_out, rw_out], axis=-1).astype(hin.dtype)
    return jnp.einsum('bsc,cd->bsd', mixed, w_out)


def setup_inputs(seed: int = 0) -> dict:
    key = jax.random.key(seed)
    ks = jax.random.split(key, 32)
    f32 = jnp.float32

    def nrm(k_, shape, scale):
        return jax.random.normal(k_, shape, f32) * scale

    def gain(k_, shape):
        return 1.0 + 0.02 * jax.random.normal(k_, shape, f32)

    w0_base = jnp.tile(jnp.linspace(-6.5, -1.5, HEAD_DIM, dtype=f32), RWKV_HEADS)
    return {
        'x': jax.random.normal(ks[0], (BATCH, SEQ, D_MODEL), f32),
        'p': jax.random.normal(ks[1], (DEPTH, BATCH, SEQ, D_PLE), f32),
        'ffn1_w_gu': nrm(ks[2], (DEPTH, D_MODEL, 2 * D_FF), D_MODEL ** -0.5),
        'ffn1_w_down': nrm(ks[3], (DEPTH, D_FF, D_MODEL), DEEPNORM_BETA * D_FF ** -0.5),
        'ln1_g': gain(ks[4], (DEPTH, D_MODEL)),
        'ln1_b': nrm(ks[5], (DEPTH, D_MODEL), 0.02),
        'w_in': nrm(ks[6], (DEPTH, D_MODEL, IN_COLS), D_MODEL ** -0.5),
        'ret_gn_g': gain(ks[7], (DEPTH, RET_WIDTH)),
        'ret_gn_b': nrm(ks[8], (DEPTH, RET_WIDTH), 0.02),
        'rw_mu': jax.random.uniform(ks[9], (DEPTH, RW_COLS), f32),
        'rw_w0': w0_base[None] + nrm(ks[10], (DEPTH, RWKV_WIDTH), 0.1),
        'rw_w_up': nrm(ks[11], (DEPTH, DECAY_LORA, RWKV_WIDTH), DECAY_LORA ** -0.5),
        'rw_a0': nrm(ks[12], (DEPTH, RWKV_WIDTH), 0.1),
        'rw_a_up': nrm(ks[13], (DEPTH, AAA_LORA, RWKV_WIDTH), AAA_LORA ** -0.5),
        'rw_g_up': nrm(ks[14], (DEPTH, GATE_LORA, RWKV_WIDTH), GATE_LORA ** -0.5),
        'rw_k_k': 0.85 + nrm(ks[15], (DEPTH, RWKV_WIDTH), 0.02),
        'rw_k_a': 1.0 + nrm(ks[16], (DEPTH, RWKV_WIDTH), 0.02),
        'rw_r_k': nrm(ks[17], (DEPTH, RWKV_HEADS, HEAD_DIM), 0.1),
        'rw_gn_g': gain(ks[18], (DEPTH, RWKV_WIDTH)),
        'rw_gn_b': nrm(ks[19], (DEPTH, RWKV_WIDTH), 0.02),
        'w_out': nrm(ks[20], (DEPTH, MIX_WIDTH, D_MODEL), DEEPNORM_BETA * MIX_WIDTH ** -0.5),
        'ln2_g': gain(ks[21], (DEPTH, D_MODEL)),
        'ln2_b': nrm(ks[22], (DEPTH, D_MODEL), 0.02),
        'ffn2_w_gu': nrm(ks[23], (DEPTH, D_MODEL, 2 * D_FF), D_MODEL ** -0.5),
        'ffn2_w_down': nrm(ks[24], (DEPTH, D_FF, D_MODEL), DEEPNORM_BETA * D_FF ** -0.5),
        'ln3_g': gain(ks[25], (DEPTH, D_MODEL)),
        'ln3_b': nrm(ks[26], (DEPTH, D_MODEL), 0.02),
        'ple_w_proj': nrm(ks[27], (DEPTH, D_PLE, D_MODEL), D_PLE ** -0.5),
        'ple_w_gate': nrm(ks[28], (DEPTH, D_MODEL, D_MODEL), D_MODEL ** -0.5),
        'ple_b_gate': nrm(ks[29], (DEPTH, D_MODEL), 0.02),
    }


def reference(x, p, ffn1_w_gu, ffn1_w_down, ln1_g, ln1_b, w_in, ret_gn_g, ret_gn_b, rw_mu,
              rw_w0, rw_w_up, rw_a0, rw_a_up, rw_g_up, rw_k_k, rw_k_a, rw_r_k, rw_gn_g, rw_gn_b,
              w_out, ln2_g, ln2_b, ffn2_w_gu, ffn2_w_down, ln3_g, ln3_b,
              ple_w_proj, ple_w_gate, ple_b_gate):
    for i in range(DEPTH):
        x = _layer_norm(DEEPNORM_ALPHA * x + 0.5 * _swiglu(x, ffn1_w_gu[i], ffn1_w_down[i]), ln1_g[i], ln1_b[i])
        mix = _token_mixer(x, w_in[i], ret_gn_g[i], ret_gn_b[i], rw_mu[i], rw_w0[i], rw_w_up[i],
                           rw_a0[i], rw_a_up[i], rw_g_up[i], rw_k_k[i], rw_k_a[i], rw_r_k[i],
                           rw_gn_g[i], rw_gn_b[i], w_out[i])
        x = _layer_norm(DEEPNORM_ALPHA * x + mix, ln2_g[i], ln2_b[i])
        x = _layer_norm(DEEPNORM_ALPHA * x + 0.5 * _swiglu(x, ffn2_w_gu[i], ffn2_w_down[i]), ln3_g[i], ln3_b[i])
        gate = jax.nn.sigmoid(jnp.einsum('bsd,de->bse', x, ple_w_gate[i]) + ple_b_gate[i])
        x = x + gate * jnp.einsum('bsp,pd->bsd', p[i], ple_w_proj[i])
    return x
```

```cpp
#include <hip/hip_runtime.h>
#include <hip/hip_cooperative_groups.h>
#include <cstdio>
#include <cstdint>
namespace cg = cooperative_groups;
namespace pg8 {
#define PG8_LAS __attribute__((address_space(3)))
typedef unsigned short bf16_t;
typedef short bf16x8 __attribute__((ext_vector_type(8)));
typedef float f32x4 __attribute__((ext_vector_type(4)));
typedef unsigned u32x4 __attribute__((ext_vector_type(4)));
constexpr int BM = 256, BK = 64, HALF = 128, HTB = HALF * BK * 2  , STAGE_BYTES = 8 * HTB, NXCD = 8, WGM = 4;

__host__ __device__ __forceinline__ int lds_byte(int r, int c) { const int st = (r >> 4) * 2 + (c >> 5), rr = r & 15, cc = c & 31, ob = rr * 64 + cc * 2; return st * 1024 + (ob ^ (((ob >> 9) & 1) << 5)); }
__host__ __device__ __forceinline__ void stage_rc(int b, int& R, int& C) { const int st = b / 1024, sb = b % 1024, swz = sb ^ (((sb >> 9) & 1) << 5); R = (st >> 1) * 16 + swz / 64; C = (st & 1) * 32 + (swz % 64) / 2; }
__host__ __device__ __forceinline__ int perm32(int rho) { const int n = rho >> 4, i = rho & 15; return 8 * (i >> 2) + 4 * n + (i & 3); }

struct Unit { int pm, pn; };
struct Gemm { const bf16_t* A; const bf16_t* Bt; int M, N, K; };

struct StaticOrder {
    int nM, nN, nwg, G, c;
    __host__ __device__ void init(int M, int N, int G_, int c_) { nM = M / BM; nN = N / BM; nwg = nM * nN; G = G_; c = c_; }
    __host__ __device__ bool next(int i, Unit& u) const {
        const long L = (long)i * G + c; if (L >= nwg) return false;
        int wgid = (int)L; { const int q = nwg / NXCD, r = nwg % NXCD, xcd = wgid % NXCD, off = wgid / NXCD; wgid = (xcd < r ? xcd * (q + 1) : r * (q + 1) + (xcd - r) * q) + off; }
        const int nig = WGM * nN, gid = wgid / nig, fm = gid * WGM, gsz = (nM - fm) < WGM ? (nM - fm) : WGM;
        u.pm = fm + ((wgid % nig) % gsz); u.pn = (wgid % nig) / gsz; return true;
    }
    __device__ __forceinline__ void a_ready(const Unit&) const {}
    __device__ __forceinline__ void done(const Unit&) const {}
};

__device__ __forceinline__ unsigned cvt_pk_bf16(float lo, float hi) { unsigned r; asm volatile("v_cvt_pk_bf16_f32 %0, %1, %2" : "=v"(r) : "v"(lo), "v"(hi)); return r; }
typedef float f32x2 __attribute__((ext_vector_type(2)));
template <class Epi, class Sched, bool ALIGN_EPI = false, bool SP2 = false>
__device__ __forceinline__ void gemm_phase(PG8_LAS unsigned char* lds, const Gemm g, const Sched& S, const Epi& E, const int tid) {
    const int wid = __builtin_amdgcn_readfirstlane(tid >> 6), lane = tid & 63, wr = wid >> 2, wc = wid & 3, fr = lane & 15, fq = lane >> 4;
    const int K = g.K, nt = K / BK;
    unsigned voffA[2], voffB[2];
#pragma unroll
    for (int i = 0; i < 2; ++i) { int R, C; stage_rc(tid * 16 + i * 8192, R, C); const int Rb = Epi::PERM ? ((R & ~31) + perm32(R & 31)) : R;
        voffA[i] = (unsigned)(R * K + C) * 2u; voffB[i] = (unsigned)(Rb * K + C) * 2u; }
    const size_t kstep = (size_t)(BK * 2);
    const size_t hstep = (size_t)HALF * K * 2;
    const size_t tstep = 2 * hstep;
    const unsigned ldsw = (unsigned)wid * 1024u;
    const int aoff = lds_byte(wr * 64 + fr, fq * 8), boff = lds_byte(wc * 32 + fr, fq * 8);
#define PG8_SA(b, h) (((b) * 2 + (h)) * HTB)
#define PG8_SB(b, h) ((4 + (b) * 2 + (h)) * HTB)
#define PG8_STAGE(bufoff, gbase, voff) do { _Pragma("unroll") for (int _i = 0; _i < 2; ++_i) \
        __builtin_amdgcn_global_load_lds((const unsigned*)((const char*)(gbase) + (voff)[_i]), (PG8_LAS unsigned*)(lds + (bufoff) + ldsw + _i * 8192), 16, 0, 0); } while (0)
#define PG8_LDA(dst, b, h) do { _Pragma("unroll") for (int m = 0; m < 4; ++m) _Pragma("unroll") for (int k = 0; k < 2; ++k) dst[m][k] = *(const PG8_LAS bf16x8*)(lds + PG8_SA(b, h) + aoff + m * 2048 + k * 1024); } while (0)
#define PG8_LDB(dst, b, h) do { _Pragma("unroll") for (int n = 0; n < 2; ++n) _Pragma("unroll") for (int k = 0; k < 2; ++k) dst[n][k] = *(const PG8_LAS bf16x8*)(lds + PG8_SB(b, h) + boff + n * 2048 + k * 1024); } while (0)
#define PG8_MMA(ai, bj, At, Bt) do { __builtin_amdgcn_s_setprio(1); _Pragma("unroll") for (int m = 0; m < 4; ++m) _Pragma("unroll") for (int n = 0; n < 2; ++n) _Pragma("unroll") for (int k = 0; k < 2; ++k) \
        acc[ai][bj][m][n] = __builtin_amdgcn_mfma_f32_16x16x32_bf16(Bt[n][k], At[m][k], acc[ai][bj][m][n], 0, 0, 0); __builtin_amdgcn_s_setprio(0); } while (0)
#define PG8_WAIT_V(n) asm volatile("s_waitcnt vmcnt(" #n ")" ::: "memory")
#define PG8_WAIT_L(n) asm volatile("s_waitcnt lgkmcnt(" #n ")" ::: "memory")
#define PG8_BAR __builtin_amdgcn_s_barrier()
#define PG8_SCHED __builtin_amdgcn_sched_barrier(0)
    Unit cur, nxt; int ui = 0;
    if (!S.next(0, cur)) return;
    f32x4 acc[2][2][4][2];
#pragma unroll
    for (int a = 0; a < 2; ++a)
#pragma unroll
        for (int b = 0; b < 2; ++b)
#pragma unroll
            for (int m = 0; m < 4; ++m)
#pragma unroll
                for (int n = 0; n < 2; ++n) acc[a][b][m][n] = (f32x4){0.f, 0.f, 0.f, 0.f};
    bf16x8 At[4][2], B0[2][2], B1[2][2];
    const char* cA = (const char*)g.A + (size_t)cur.pm * tstep; const char* cB = (const char*)g.Bt + (size_t)cur.pn * tstep;
    S.a_ready(cur);
    if constexpr (SP2) {
        PG8_STAGE(PG8_SB(0, 0), cB, voffB); PG8_STAGE(PG8_SB(0, 1), cB + hstep, voffB); PG8_STAGE(PG8_SA(0, 0), cA, voffA); PG8_STAGE(PG8_SA(0, 1), cA + hstep, voffA);
        if (wr == 1) PG8_BAR;
        PG8_WAIT_V(2); PG8_BAR;
        PG8_STAGE(PG8_SB(1, 0), cB + kstep, voffB); PG8_STAGE(PG8_SA(1, 0), cA + kstep, voffA); PG8_STAGE(PG8_SB(1, 1), cB + hstep + kstep, voffB);
        PG8_WAIT_V(6); PG8_BAR;
    } else {
        PG8_STAGE(PG8_SB(0, 0), cB, voffB); PG8_STAGE(PG8_SA(0, 0), cA, voffA); PG8_STAGE(PG8_SB(0, 1), cB + hstep, voffB); PG8_STAGE(PG8_SA(0, 1), cA + hstep, voffA);
        if (wr == 1) PG8_BAR;
        PG8_WAIT_V(4); PG8_BAR;
        PG8_STAGE(PG8_SB(1, 0), cB + kstep, voffB); PG8_STAGE(PG8_SA(1, 0), cA + kstep, voffA); PG8_STAGE(PG8_SB(1, 1), cB + hstep + kstep, voffB);
        PG8_WAIT_V(6); PG8_BAR;
    }
    for (;;) {
        const bool has_next = S.next(ui + 1, nxt);
        const char* nA = has_next ? (const char*)g.A + (size_t)nxt.pm * tstep : cA; const char* nB = has_next ? (const char*)g.Bt + (size_t)nxt.pn * tstep : cB;
        for (int t = 0; t < nt; t += 2) {
            const bool last = (t == nt - 2);
            const char* a1 = cA + (size_t)(t + 1) * kstep;
            const char* a2 = last ? nA : cA + (size_t)(t + 2) * kstep; const char* b2 = last ? nB : cB + (size_t)(t + 2) * kstep;
            const char* a3 = a2 + kstep; const char* b3 = b2 + kstep;
            if (last && has_next) S.a_ready(nxt);
            if constexpr (SP2) {
            PG8_LDB(B0, 0, 0); PG8_LDB(B1, 0, 1); PG8_SCHED; PG8_LDA(At, 0, 0); PG8_STAGE(PG8_SA(1, 1), a1 + hstep, voffA);
            PG8_WAIT_V(8); PG8_WAIT_L(0); PG8_BAR; PG8_MMA(0, 0, At, B0); PG8_MMA(0, 1, At, B1); PG8_BAR; PG8_SCHED;
            PG8_LDA(At, 0, 1); PG8_STAGE(PG8_SB(0, 0), b2, voffB); PG8_STAGE(PG8_SB(0, 1), b2 + hstep, voffB); PG8_STAGE(PG8_SA(0, 0), a2, voffA);
            PG8_WAIT_V(8); PG8_WAIT_L(0); PG8_BAR; PG8_MMA(1, 0, At, B0); PG8_MMA(1, 1, At, B1); PG8_BAR; PG8_SCHED;
            PG8_LDB(B0, 1, 0); PG8_LDB(B1, 1, 1); PG8_SCHED; PG8_LDA(At, 1, 0); PG8_STAGE(PG8_SA(0, 1), a2 + hstep, voffA);
            PG8_WAIT_V(8); PG8_WAIT_L(0); PG8_BAR; PG8_MMA(0, 0, At, B0); PG8_MMA(0, 1, At, B1); PG8_BAR; PG8_SCHED;
            PG8_LDA(At, 1, 1); PG8_STAGE(PG8_SB(1, 0), b3, voffB); PG8_STAGE(PG8_SB(1, 1), b3 + hstep, voffB); PG8_STAGE(PG8_SA(1, 0), a3, voffA);
            PG8_WAIT_V(8); PG8_WAIT_L(0); PG8_BAR; PG8_MMA(1, 0, At, B0); PG8_MMA(1, 1, At, B1); PG8_BAR; PG8_SCHED;
            } else {
            PG8_LDB(B0, 0, 0); PG8_SCHED; PG8_LDA(At, 0, 0); PG8_STAGE(PG8_SA(1, 1), a1 + hstep, voffA);
            PG8_WAIT_L(8); PG8_BAR; PG8_WAIT_L(0); PG8_MMA(0, 0, At, B0); PG8_BAR; PG8_SCHED;
            PG8_LDB(B1, 0, 1); PG8_STAGE(PG8_SB(0, 0), b2, voffB);
            PG8_BAR; PG8_WAIT_L(0); PG8_MMA(0, 1, At, B1); PG8_BAR;
            PG8_LDA(At, 0, 1); PG8_STAGE(PG8_SA(0, 0), a2, voffA);
            PG8_BAR; PG8_WAIT_L(0); PG8_MMA(1, 0, At, B0); PG8_BAR; PG8_SCHED;
            PG8_STAGE(PG8_SB(0, 1), b2 + hstep, voffB);
            PG8_WAIT_V(6); PG8_BAR; PG8_MMA(1, 1, At, B1); PG8_BAR;
            PG8_LDB(B0, 1, 0); PG8_SCHED; PG8_LDA(At, 1, 0); PG8_STAGE(PG8_SA(0, 1), a2 + hstep, voffA);
            PG8_WAIT_L(8); PG8_BAR; PG8_WAIT_L(0); PG8_MMA(0, 0, At, B0); PG8_BAR; PG8_SCHED;
            PG8_LDB(B1, 1, 1); PG8_STAGE(PG8_SB(1, 0), b3, voffB);
            PG8_BAR; PG8_WAIT_L(0); PG8_MMA(0, 1, At, B1); PG8_BAR;
            PG8_LDA(At, 1, 1); PG8_STAGE(PG8_SA(1, 0), a3, voffA);
            PG8_BAR; PG8_WAIT_L(0); PG8_MMA(1, 0, At, B0); PG8_BAR; PG8_SCHED;
            PG8_STAGE(PG8_SB(1, 1), b3 + hstep, voffB);
            PG8_WAIT_V(6); PG8_BAR; PG8_MMA(1, 1, At, B1); PG8_BAR;
            }
        }
        if constexpr (ALIGN_EPI) { if (wr == 0) PG8_BAR; }
        if constexpr (!Epi::AFTER_DRAIN) { E(acc, cur, wr, wc, fr, fq); S.done(cur); }
        if (!has_next) break;
#pragma unroll
        for (int a = 0; a < 2; ++a)
#pragma unroll
            for (int b = 0; b < 2; ++b)
#pragma unroll
                for (int m = 0; m < 4; ++m)
#pragma unroll
                    for (int n = 0; n < 2; ++n) acc[a][b][m][n] = (f32x4){0.f, 0.f, 0.f, 0.f};
        cur = nxt; cA = nA; cB = nB; ++ui;
        if constexpr (ALIGN_EPI) { if (wr == 1) PG8_BAR; }
    }
    PG8_WAIT_V(0);
    if constexpr (!ALIGN_EPI) { if (wr == 0) PG8_BAR; }
    PG8_BAR;
    if constexpr (Epi::AFTER_DRAIN) { E.fused(acc, cur, wr, wc, fr, fq, lds, wid, lane); S.done(cur); }
#undef PG8_SA
#undef PG8_SB
#undef PG8_STAGE
#undef PG8_LDA
#undef PG8_LDB
#undef PG8_MMA
#undef PG8_WAIT_V
#undef PG8_WAIT_L
#undef PG8_BAR
#undef PG8_SCHED
}
}

#define DI __device__ __forceinline__
#define LAS __attribute__((address_space(3)))
using pg8::bf16_t; using pg8::f32x4; using pg8::u32x4; using pg8::Unit; using pg8::cvt_pk_bf16;
typedef unsigned u32x2 __attribute__((ext_vector_type(2)));
typedef float f32x2v __attribute__((ext_vector_type(2)));

constexpr int M = 16384, D = 1024, SEQ = 4096, FF = 2816, NGU = 5632, NIN = 3872, NINP = 4096, KL = 384, NL = 1536, DP = 256;
constexpr int TR = 512, NR = SEQ / TR, REC = 384;
constexpr float ALPHA = 1.189207115002721f;
constexpr size_t MiB = (size_t)1 << 20;
constexpr size_t WS_ST = MiB / 2, WS_CS = 1 * MiB, WS_WGU = 2 * MiB, WS_WD = 13 * MiB, WS_WIN = 19 * MiB, WS_WLORA = 27 * MiB, WS_WOUT = 29 * MiB,
                 WS_WPG = 31 * MiB, WS_WPP = 33 * MiB, WS_PB = 34 * MiB, WS_XB = 42 * MiB, WS_A = 74 * MiB, WS_B = 162 * MiB, WS_SC = 226 * MiB, WS_END = 254 * MiB;
constexpr int LDS_BYTES = 136 * 1024;
constexpr size_t WS_C1WIN = 16384, WS_C2WIN = WS_C1WIN + 16384, WS_C1GU = WS_C2WIN + 16384, WS_C2GU = WS_C1GU + 24576, WS_C1PG = WS_C2GU + 24576, WS_C2PG = WS_C1PG + 4096, WS_RSTAT = 131072, WS_ZERO_BYTES = 524288;
constexpr float LN_EPS = 1e-5f;
#ifndef PG_ALIGN
#define PG_ALIGN true
#endif
#ifndef DUP_GEMM
#define DUP_GEMM 1
#endif
#ifndef DUP_RET
#define DUP_RET 1
#endif
#ifndef DUP_MISC
#define DUP_MISC 1
#endif

constexpr int NPH = 12 + (NR + 2);

DI int launder_v(int x) { asm volatile("" : "+v"(x)); return x; }
DI float bf2f(bf16_t v) { return __uint_as_float((unsigned)v << 16); }
DI bf16_t f2bf(float x) { return (bf16_t)(cvt_pk_bf16(x, 0.f) & 0xffffu); }
template <int CTRL> DI float dpp_f(float x) { return __builtin_bit_cast(float, __builtin_amdgcn_update_dpp(0, __builtin_bit_cast(int, x), CTRL, 0xf, 0xf, true)); }
DI float red16(float x) { x += dpp_f<0xB1>(x); x += dpp_f<0x4E>(x); x += dpp_f<0x141>(x); x += dpp_f<0x140>(x); return x; }
DI float sum_rows4(float x) {
    float a = x, b = x; asm("s_nop 1\n\tv_permlane16_swap_b32 %0, %1\n\ts_nop 1" : "+v"(a), "+v"(b)); x = a + b;
    a = x; b = x; asm("s_nop 1\n\tv_permlane32_swap_b32 %0, %1\n\ts_nop 1" : "+v"(a), "+v"(b)); return a + b;
}
DI float wave_sum(float v) { return sum_rows4(red16(v)); }
DI float sigmoidf_(float x) { return 1.0f / (1.0f + __expf(-x)); }
DI float silu_fast(float x) { return x * __builtin_amdgcn_rcpf(1.0f + __expf(-x)); }

DI void row_stats(const float* stat, int row, float& mu, float& rstd) {
    const f32x2v st = *(const f32x2v*)(stat + 2 * (size_t)row); mu = st.x * (1.0f / D); const float var = fmaxf(st.y * (1.0f / D) - mu * mu, 0.f); rstd = 1.0f / sqrtf(var + LN_EPS);
}
DI f32x4 ln_fix(f32x4 a, float mu, float rstd, f32x4 c1, f32x4 c2) { return (a - c1 * mu) * rstd + c2; }
struct EpiGU {
    static constexpr bool PERM = true, AFTER_DRAIN = false; bf16_t* H; const float* stat; const float* c1; const float* c2;
    DI void operator()(const f32x4 (&acc)[2][2][4][2], const Unit& u, int wr, int wc, int fr, int fq) const {
        const int row0 = u.pm * 256 + wr * 64 + fr, col0 = u.pn * 128 + wc * 32 + 8 * fq;
        f32x4 cc1[4], cc2[4];
        if (stat) { const int pc = u.pn * 256 + wc * 32 + 8 * fq;
            cc1[0] = *(const f32x4*)(c1 + pc); cc1[1] = *(const f32x4*)(c1 + pc + 4); cc1[2] = *(const f32x4*)(c1 + pc + 128); cc1[3] = *(const f32x4*)(c1 + pc + 132);
            cc2[0] = *(const f32x4*)(c2 + pc); cc2[1] = *(const f32x4*)(c2 + pc + 4); cc2[2] = *(const f32x4*)(c2 + pc + 128); cc2[3] = *(const f32x4*)(c2 + pc + 132); }
#pragma unroll
        for (int ai = 0; ai < 2; ++ai)
#pragma unroll
            for (int m = 0; m < 4; ++m) {
                bf16_t* p = H + (size_t)(row0 + ai * 128 + m * 16) * FF + col0;
                f32x4 g0 = acc[ai][0][m][0], g1 = acc[ai][0][m][1], u0 = acc[ai][1][m][0], u1 = acc[ai][1][m][1];
                if (stat) { float mu, rstd; row_stats(stat, row0 + ai * 128 + m * 16, mu, rstd);
                    g0 = ln_fix(g0, mu, rstd, cc1[0], cc2[0]); g1 = ln_fix(g1, mu, rstd, cc1[1], cc2[1]); u0 = ln_fix(u0, mu, rstd, cc1[2], cc2[2]); u1 = ln_fix(u1, mu, rstd, cc1[3], cc2[3]); }
                u32x4 w;
                w.x = cvt_pk_bf16(silu_fast(g0[0]) * u0[0], silu_fast(g0[1]) * u0[1]); w.y = cvt_pk_bf16(silu_fast(g0[2]) * u0[2], silu_fast(g0[3]) * u0[3]);
                w.z = cvt_pk_bf16(silu_fast(g1[0]) * u1[0], silu_fast(g1[1]) * u1[1]); w.w = cvt_pk_bf16(silu_fast(g1[2]) * u1[2], silu_fast(g1[3]) * u1[3]);
                *(u32x4*)p = w;
            }
    }
};
struct EpiRes {
    static constexpr bool PERM = true, AFTER_DRAIN = false; const float* Xraw; float* Yio; bf16_t* YB; float* stat_out; const float* ln_stat; const float* ln_g; const float* ln_b; float s;
    DI void operator()(const f32x4 (&acc)[2][2][4][2], const Unit& u, int wr, int wc, int fr, int fq) const {
        const int row0 = u.pm * 256 + wr * 64 + fr, col0 = u.pn * 256 + wc * 32 + 8 * fq;
        f32x4 gv[2][2], bv[2][2];
        if (ln_stat) {
#pragma unroll
            for (int bj = 0; bj < 2; ++bj) { gv[bj][0] = *(const f32x4*)(ln_g + col0 + bj * 128); gv[bj][1] = *(const f32x4*)(ln_g + col0 + bj * 128 + 4); bv[bj][0] = *(const f32x4*)(ln_b + col0 + bj * 128); bv[bj][1] = *(const f32x4*)(ln_b + col0 + bj * 128 + 4); }
        }
#pragma unroll
        for (int ai = 0; ai < 2; ++ai)
#pragma unroll
            for (int m = 0; m < 4; ++m) {
                const int row = row0 + ai * 128 + m * 16; float mu = 0.f, rstd = 1.f; if (ln_stat) row_stats(ln_stat, row, mu, rstd);
                float rs = 0.f, rq = 0.f;
#pragma unroll
                for (int bj = 0; bj < 2; ++bj) {
                    const size_t off = (size_t)row * D + col0 + bj * 128;
                    f32x4 x0, x1;
                    if (ln_stat) { x0 = *(const f32x4*)(Yio + off); x1 = *(const f32x4*)(Yio + off + 4);
                        x0 = (x0 - mu) * rstd * gv[bj][0] + bv[bj][0]; x1 = (x1 - mu) * rstd * gv[bj][1] + bv[bj][1]; }
                    else { x0 = *(const f32x4*)(Xraw + off); x1 = *(const f32x4*)(Xraw + off + 4); }
                    const f32x4 y0 = x0 * ALPHA + acc[ai][bj][m][0] * s, y1 = x1 * ALPHA + acc[ai][bj][m][1] * s;
                    *(f32x4*)(Yio + off) = y0; *(f32x4*)(Yio + off + 4) = y1;
                    u32x4 w; w.x = cvt_pk_bf16(y0[0], y0[1]); w.y = cvt_pk_bf16(y0[2], y0[3]); w.z = cvt_pk_bf16(y1[0], y1[1]); w.w = cvt_pk_bf16(y1[2], y1[3]);
                    *(u32x4*)(YB + off) = w;
                    rs += (y0[0] + y0[1]) + (y0[2] + y0[3]) + (y1[0] + y1[1]) + (y1[2] + y1[3]);
                    rq += (y0[0] * y0[0] + y0[1] * y0[1]) + (y0[2] * y0[2] + y0[3] * y0[3]) + (y1[0] * y1[0] + y1[1] * y1[1]) + (y1[2] * y1[2] + y1[3] * y1[3]);
                }
                rs = sum_rows4(rs); rq = sum_rows4(rq);
                if (fq == 0) { atomicAdd(stat_out + 2 * (size_t)row, rs); atomicAdd(stat_out + 2 * (size_t)row + 1, rq); }
            }
    }
};
struct EpiWin {
    static constexpr bool PERM = true, AFTER_DRAIN = false; bf16_t* ZRET; bf16_t* ZRW; const float* CS; const float* stat; const float* c1; const float* c2;
    DI void operator()(const f32x4 (&acc)[2][2][4][2], const Unit& u, int wr, int wc, int fr, int fq) const {
        const int row0 = u.pm * 256 + wr * 64 + fr;
        f32x4 cc1[4], cc2[4];
        { const int pc = u.pn * 256 + wc * 32 + 8 * fq;
            cc1[0] = *(const f32x4*)(c1 + pc); cc1[1] = *(const f32x4*)(c1 + pc + 4); cc1[2] = *(const f32x4*)(c1 + pc + 128); cc1[3] = *(const f32x4*)(c1 + pc + 132);
            cc2[0] = *(const f32x4*)(c2 + pc); cc2[1] = *(const f32x4*)(c2 + pc + 4); cc2[2] = *(const f32x4*)(c2 + pc + 128); cc2[3] = *(const f32x4*)(c2 + pc + 132); }
        if (u.pn < 4) {
            const int sec = u.pn >> 1, head = (u.pn & 1) * 4 + wc; const float sc = sec ? 0.125f : 1.0f;
#pragma unroll
            for (int ai = 0; ai < 2; ++ai)
#pragma unroll
                for (int m = 0; m < 4; ++m) {
                    const int row = row0 + ai * 128 + m * 16, pos = row & (SEQ - 1);
                    const f32x4* cs = (const f32x4*)(CS + ((size_t)pos * 32 + 8 * fq) * 2);
                    const f32x4 c01 = cs[0], c23 = cs[1], c45 = cs[2], c67 = cs[3];
                    float mu, rstd; row_stats(stat, row, mu, rstd);
                    const f32x4 a0 = ln_fix(acc[ai][0][m][0], mu, rstd, cc1[0], cc2[0]), a1 = ln_fix(acc[ai][0][m][1], mu, rstd, cc1[1], cc2[1]),
                                b0 = ln_fix(acc[ai][1][m][0], mu, rstd, cc1[2], cc2[2]), b1 = ln_fix(acc[ai][1][m][1], mu, rstd, cc1[3], cc2[3]);
                    u32x4 o1, o2;
                    o1.x = cvt_pk_bf16((a0[0] * c01[0] - b0[0] * c01[1]) * sc, (a0[1] * c01[2] - b0[1] * c01[3]) * sc);
                    o1.y = cvt_pk_bf16((a0[2] * c23[0] - b0[2] * c23[1]) * sc, (a0[3] * c23[2] - b0[3] * c23[3]) * sc);
                    o1.z = cvt_pk_bf16((a1[0] * c45[0] - b1[0] * c45[1]) * sc, (a1[1] * c45[2] - b1[1] * c45[3]) * sc);
                    o1.w = cvt_pk_bf16((a1[2] * c67[0] - b1[2] * c67[1]) * sc, (a1[3] * c67[2] - b1[3] * c67[3]) * sc);
                    o2.x = cvt_pk_bf16((a0[0] * c01[1] + b0[0] * c01[0]) * sc, (a0[1] * c01[3] + b0[1] * c01[2]) * sc);
                    o2.y = cvt_pk_bf16((a0[2] * c23[1] + b0[2] * c23[0]) * sc, (a0[3] * c23[3] + b0[3] * c23[2]) * sc);
                    o2.z = cvt_pk_bf16((a1[0] * c45[1] + b1[0] * c45[0]) * sc, (a1[1] * c45[3] + b1[1] * c45[2]) * sc);
                    o2.w = cvt_pk_bf16((a1[2] * c67[1] + b1[2] * c67[0]) * sc, (a1[3] * c67[3] + b1[3] * c67[2]) * sc);
                    bf16_t* p = ZRET + (size_t)row * 2048 + sec * 512 + head * 64 + 8 * fq;
                    *(u32x4*)p = o1; *(u32x4*)(p + 32) = o2;
                }
        } else {
            bf16_t* base = (u.pn < 8) ? ZRET + u.pn * 256 : ZRW + (u.pn - 8) * 256;
            const int col0 = wc * 32 + 8 * fq;
#pragma unroll
            for (int ai = 0; ai < 2; ++ai)
#pragma unroll
                for (int m = 0; m < 4; ++m)
#pragma unroll
                    for (int bj = 0; bj < 2; ++bj) {
                        float mu, rstd; row_stats(stat, row0 + ai * 128 + m * 16, mu, rstd);
                        const f32x4 v0 = ln_fix(acc[ai][bj][m][0], mu, rstd, cc1[2 * bj], cc2[2 * bj]), v1 = ln_fix(acc[ai][bj][m][1], mu, rstd, cc1[2 * bj + 1], cc2[2 * bj + 1]); u32x4 w;
                        w.x = cvt_pk_bf16(v0[0], v0[1]); w.y = cvt_pk_bf16(v0[2], v0[3]); w.z = cvt_pk_bf16(v1[0], v1[1]); w.w = cvt_pk_bf16(v1[2], v1[3]);
                        *(u32x4*)(base + (size_t)(row0 + ai * 128 + m * 16) * 2048 + col0 + bj * 128) = w;
                    }
        }
    }
};
DI float decay_from_lora(float x) { const float nx = -x; const float sp = fmaxf(nx, 0.f) + log1pf(__expf(-fabsf(nx))); return __expf(-__expf(-sp - 0.5f)); }
struct EpiLora {
    static constexpr bool PERM = true, AFTER_DRAIN = false; float* LW; bf16_t* LA2; bf16_t* LG; const float* w0; const float* a0;
    DI void operator()(const f32x4 (&acc)[2][2][4][2], const Unit& u, int wr, int wc, int fr, int fq) const {
        const int row0 = u.pm * 256 + wr * 64 + fr, kind = u.pn >> 1, cb = (u.pn & 1) * 256 + wc * 32 + 8 * fq;
        if (kind == 0) {
#pragma unroll
            for (int bj = 0; bj < 2; ++bj) {
                const f32x4 bi0 = *(const f32x4*)(w0 + cb + bj * 128), bi1 = *(const f32x4*)(w0 + cb + bj * 128 + 4);
#pragma unroll
                for (int ai = 0; ai < 2; ++ai)
#pragma unroll
                    for (int m = 0; m < 4; ++m) {
                        const size_t off = (size_t)(row0 + ai * 128 + m * 16) * 512 + cb + bj * 128;
                        const f32x4 v0 = acc[ai][bj][m][0] + bi0, v1 = acc[ai][bj][m][1] + bi1; f32x4 o0, o1;
                        o0 = v0; o1 = v1;
                        *(f32x4*)(LW + off) = o0; *(f32x4*)(LW + off + 4) = o1;
                    }
            }
        } else if (kind == 1) {
#pragma unroll
            for (int bj = 0; bj < 2; ++bj) {
                const f32x4 bi0 = *(const f32x4*)(a0 + cb + bj * 128), bi1 = *(const f32x4*)(a0 + cb + bj * 128 + 4);
#pragma unroll
                for (int ai = 0; ai < 2; ++ai)
#pragma unroll
                    for (int m = 0; m < 4; ++m) {
                        const size_t off = (size_t)(row0 + ai * 128 + m * 16) * 512 + cb + bj * 128;
                        const f32x4 v0 = acc[ai][bj][m][0] + bi0, v1 = acc[ai][bj][m][1] + bi1; u32x4 w;
                        w.x = cvt_pk_bf16(v0[0], v0[1]); w.y = cvt_pk_bf16(v0[2], v0[3]); w.z = cvt_pk_bf16(v1[0], v1[1]); w.w = cvt_pk_bf16(v1[2], v1[3]);
                        *(u32x4*)(LA2 + off) = w;
                    }
            }
        } else {
#pragma unroll
            for (int bj = 0; bj < 2; ++bj)
#pragma unroll
                for (int ai = 0; ai < 2; ++ai)
#pragma unroll
                    for (int m = 0; m < 4; ++m) {
                        const size_t off = (size_t)(row0 + ai * 128 + m * 16) * 512 + cb + bj * 128;
                        const f32x4 v0 = acc[ai][bj][m][0], v1 = acc[ai][bj][m][1]; u32x4 w;
                        w.x = cvt_pk_bf16(v0[0], v0[1]); w.y = cvt_pk_bf16(v0[2], v0[3]); w.z = cvt_pk_bf16(v1[0], v1[1]); w.w = cvt_pk_bf16(v1[2], v1[3]);
                        *(u32x4*)(LG + off) = w;
                    }
        }
    }
};
struct EpiProj {
    static constexpr bool PERM = true, AFTER_DRAIN = false; bf16_t* P;
    DI void operator()(const f32x4 (&acc)[2][2][4][2], const Unit& u, int wr, int wc, int fr, int fq) const {
        const int row0 = u.pm * 256 + wr * 64 + fr, col0 = u.pn * 256 + wc * 32 + 8 * fq;
#pragma unroll
        for (int ai = 0; ai < 2; ++ai)
#pragma unroll
            for (int m = 0; m < 4; ++m)
#pragma unroll
                for (int bj = 0; bj < 2; ++bj) {
                    const size_t off = (size_t)(row0 + ai * 128 + m * 16) * D + col0 + bj * 128;
                    const f32x4 v0 = acc[ai][bj][m][0], v1 = acc[ai][bj][m][1]; u32x4 w;
                    w.x = cvt_pk_bf16(v0[0], v0[1]); w.y = cvt_pk_bf16(v0[2], v0[3]); w.z = cvt_pk_bf16(v1[0], v1[1]); w.w = cvt_pk_bf16(v1[2], v1[3]);
                    *(u32x4*)(P + off) = w;
                }
    }
};
struct EpiGate {
    static constexpr bool PERM = true, AFTER_DRAIN = false; float* XO; const bf16_t* P; const float* bias; const float* stat; const float* c1; const float* c2; const float* ln_g; const float* ln_b;
    DI void operator()(const f32x4 (&acc)[2][2][4][2], const Unit& u, int wr, int wc, int fr, int fq) const {
        const int row0 = u.pm * 256 + wr * 64 + fr, col0 = u.pn * 256 + wc * 32 + 8 * fq;
#pragma unroll
        for (int ai = 0; ai < 2; ++ai)
#pragma unroll
            for (int m = 0; m < 4; ++m) {
                const int row = row0 + ai * 128 + m * 16; float mu, rstd; row_stats(stat, row, mu, rstd);
#pragma unroll
                for (int bj = 0; bj < 2; ++bj) {
                    const int col = col0 + bj * 128; const size_t off = (size_t)row * D + col;
                    const f32x4 bb0 = *(const f32x4*)(bias + col), bb1 = *(const f32x4*)(bias + col + 4);
                    const f32x4 g0 = ln_fix(acc[ai][bj][m][0], mu, rstd, *(const f32x4*)(c1 + col), *(const f32x4*)(c2 + col)) + bb0, g1 = ln_fix(acc[ai][bj][m][1], mu, rstd, *(const f32x4*)(c1 + col + 4), *(const f32x4*)(c2 + col + 4)) + bb1;
                    f32x4 x0 = *(const f32x4*)(XO + off), x1 = *(const f32x4*)(XO + off + 4); const u32x4 pw = *(const u32x4*)(P + off);
                    const f32x4 p0 = (f32x4){__uint_as_float(pw.x << 16), __uint_as_float(pw.x & 0xffff0000u), __uint_as_float(pw.y << 16), __uint_as_float(pw.y & 0xffff0000u)},
                                p1 = (f32x4){__uint_as_float(pw.z << 16), __uint_as_float(pw.z & 0xffff0000u), __uint_as_float(pw.w << 16), __uint_as_float(pw.w & 0xffff0000u)};
                    x0 = (x0 - mu) * rstd * *(const f32x4*)(ln_g + col) + *(const f32x4*)(ln_b + col); x1 = (x1 - mu) * rstd * *(const f32x4*)(ln_g + col + 4) + *(const f32x4*)(ln_b + col + 4);
                    f32x4 o0, o1;
#pragma unroll
                    for (int e = 0; e < 4; ++e) { o0[e] = x0[e] + sigmoidf_(g0[e]) * p0[e]; o1[e] = x1[e] + sigmoidf_(g1[e]) * p1[e]; }
                    *(f32x4*)(XO + off) = o0; *(f32x4*)(XO + off + 4) = o1;
                }
            }
    }
};

struct Ctx { int tid, lane, wave, bx, G, gw, NGW, gtid, NGT; LAS unsigned char* lds; };

DI void transpose_item(const float* __restrict__ W, int N, bf16_t* __restrict__ WT, int K, int dst_row0, int k0, int n0, LAS float* scr, int lane,
                       const float* lng = nullptr, const float* lnb = nullptr, float* c1 = nullptr, float* c2 = nullptr) {
    const int kr = lane >> 3, nq = (lane & 7) * 4;
    f32x4 v[8];
#pragma unroll
    for (int i = 0; i < 8; ++i) v[i] = *(const f32x4*)(W + (size_t)(k0 + kr + 8 * i) * N + n0 + nq);
    if (lng) {
        f32x4 cp = (f32x4){0.f, 0.f, 0.f, 0.f};
#pragma unroll
        for (int i = 0; i < 8; ++i) { cp = cp + v[i] * lnb[k0 + kr + 8 * i]; v[i] = v[i] * lng[k0 + kr + 8 * i]; }
#pragma unroll
        for (int j = 0; j < 4; ++j) { float t = cp[j]; t += __shfl_xor(t, 8); t += __shfl_xor(t, 16); t += __shfl_xor(t, 32); cp[j] = t; }
        if (lane < 8) {
#pragma unroll
            for (int j = 0; j < 4; ++j) atomicAdd(c2 + dst_row0 + nq + j, cp[j]);
        }
    }
#pragma unroll
    for (int i = 0; i < 8; ++i) { LAS float* d = scr + (kr + 8 * i) * 33 + nq; d[0] = v[i][0]; d[1] = v[i][1]; d[2] = v[i][2]; d[3] = v[i][3]; }
    asm volatile("s_waitcnt lgkmcnt(0)" ::: "memory");
    const int c = lane & 7;
#pragma unroll
    for (int j = 0; j < 4; ++j) { const int n = (lane >> 3) + 8 * j; const LAS float* s = scr + (8 * c) * 33 + n;
        u32x4 o; o.x = cvt_pk_bf16(s[0], s[33]); o.y = cvt_pk_bf16(s[66], s[99]); o.z = cvt_pk_bf16(s[132], s[165]); o.w = cvt_pk_bf16(s[198], s[231]);
        *(u32x4*)(WT + (size_t)(dst_row0 + n) * K + k0 + 8 * c) = o;
        if (lng) {
            float t = 0.f;
#pragma unroll
            for (int e = 0; e < 4; ++e) t += __uint_as_float(o[e] << 16) + __uint_as_float(o[e] & 0xffff0000u);
            t += __shfl_xor(t, 1); t += __shfl_xor(t, 2); t += __shfl_xor(t, 4);
            if (c == 0) atomicAdd(c1 + dst_row0 + n, t);
        } }
    asm volatile("s_waitcnt lgkmcnt(0)" ::: "memory");
}
DI int gu_dst_row(int c0) { const int isup = c0 >= FF; const int c = isup ? c0 - FF : c0; return 256 * (c >> 7) + 128 * isup + (c & 127); }
DI int win_dst_row(int c0) {
    if (c0 < 1024) { const int sec = c0 >> 9, hh = (c0 & 511) >> 6, half = (c0 & 63) >> 5; return 256 * (sec * 2 + (hh >> 2)) + 128 * half + 32 * (hh & 3); }
    return c0;
}
DI void cvt_rows_bf16(const Ctx& c, const float* src, bf16_t* dst, size_t n4) {
    for (size_t i = c.gtid; i < n4; i += c.NGT) { const f32x4 v = ((const f32x4*)src)[i]; u32x2 o; o.x = cvt_pk_bf16(v[0], v[1]); o.y = cvt_pk_bf16(v[2], v[3]); ((u32x2*)dst)[i] = o; }
}
DI void convert_ffn(const Ctx& c, const float* wgu, const float* wd, bf16_t* Wgu_t, bf16_t* Wd_t, const float* lng = nullptr, const float* lnb = nullptr, float* c1 = nullptr, float* c2 = nullptr) {
    LAS float* scr = (LAS float*)(c.lds + c.wave * 8448);
    for (int it = c.gw; it < 2816 + 1408; it += c.NGW) {
        if (it < 2816) { const int kb = it / 176, nb = it % 176; transpose_item(wgu, NGU, Wgu_t, D, gu_dst_row(32 * nb), 64 * kb, 32 * nb, scr, c.lane, lng, lnb, c1, c2); }
        else { const int r = it - 2816, kb = r / 32, nb = r % 32; transpose_item(wd, D, Wd_t, FF, 32 * nb, 64 * kb, 32 * nb, scr, c.lane); }
    }
}
DI void layer_norm_rows(const Ctx& c, const float* Y, const float* g, const float* b, float* XF, bf16_t* XB) {
    const f32x4 g0 = ((const f32x4*)g)[c.lane], g1 = ((const f32x4*)g)[c.lane + 64], g2 = ((const f32x4*)g)[c.lane + 128], g3 = ((const f32x4*)g)[c.lane + 192];
    const f32x4 b0 = ((const f32x4*)b)[c.lane], b1 = ((const f32x4*)b)[c.lane + 64], b2 = ((const f32x4*)b)[c.lane + 128], b3 = ((const f32x4*)b)[c.lane + 192];
    for (int m = c.gw; m < M; m += c.NGW) {
        const f32x4* yr = (const f32x4*)(Y + (size_t)m * D) + c.lane;
        f32x4 v0 = yr[0], v1 = yr[64], v2 = yr[128], v3 = yr[192];
        float s = (v0[0] + v0[1] + v0[2] + v0[3]) + (v1[0] + v1[1] + v1[2] + v1[3]) + (v2[0] + v2[1] + v2[2] + v2[3]) + (v3[0] + v3[1] + v3[2] + v3[3]);
        const float mean = wave_sum(s) * (1.0f / D);
        v0 = v0 - mean; v1 = v1 - mean; v2 = v2 - mean; v3 = v3 - mean;
        float q = (v0[0] * v0[0] + v0[1] * v0[1] + v0[2] * v0[2] + v0[3] * v0[3]) + (v1[0] * v1[0] + v1[1] * v1[1] + v1[2] * v1[2] + v1[3] * v1[3])
                + (v2[0] * v2[0] + v2[1] * v2[1] + v2[2] * v2[2] + v2[3] * v2[3]) + (v3[0] * v3[0] + v3[1] * v3[1] + v3[2] * v3[2] + v3[3] * v3[3]);
        const float rstd = 1.0f / sqrtf(wave_sum(q) * (1.0f / D) + 1e-5f);
        v0 = v0 * rstd * g0 + b0; v1 = v1 * rstd * g1 + b1; v2 = v2 * rstd * g2 + b2; v3 = v3 * rstd * g3 + b3;
        f32x4* xo = (f32x4*)(XF + (size_t)m * D) + c.lane; xo[0] = v0; xo[64] = v1; xo[128] = v2; xo[192] = v3;
        u32x2* bo = (u32x2*)(XB + (size_t)m * D) + c.lane; u32x2 o;
        o.x = cvt_pk_bf16(v0[0], v0[1]); o.y = cvt_pk_bf16(v0[2], v0[3]); bo[0] = o;
        o.x = cvt_pk_bf16(v1[0], v1[1]); o.y = cvt_pk_bf16(v1[2], v1[3]); bo[64] = o;
        o.x = cvt_pk_bf16(v2[0], v2[1]); o.y = cvt_pk_bf16(v2[2], v2[3]); bo[128] = o;
        o.x = cvt_pk_bf16(v3[0], v3[1]); o.y = cvt_pk_bf16(v3[2], v3[3]); bo[192] = o;
    }
}
DI float zshift(const bf16_t* ZRW, size_t t, int tin, int col, const float* mu) {
    const float z = bf2f(ZRW[t * 2048 + col]); const float zp = tin ? bf2f(ZRW[(t - 1) * 2048 + col]) : 0.f;
    return z + (zp - z) * mu[col];
}
DI void prep_lora_a(const Ctx& c, const bf16_t* ZRW, const float* mu, bf16_t* LA) {
    for (int i = c.gtid; i < M * (KL / 8); i += c.NGT) {
        const int t = i / (KL / 8), g = i % (KL / 8); u32x4 o = (u32x4){0u, 0u, 0u, 0u};
        if (g < 36) {
            const int col = 1536 + 8 * g;
            const u32x4 zc = *(const u32x4*)(ZRW + (size_t)t * 2048 + col); u32x4 zp = (u32x4){0u, 0u, 0u, 0u};
            if (t & (SEQ - 1)) zp = *(const u32x4*)(ZRW + (size_t)(t - 1) * 2048 + col);
            const f32x4 m0 = *(const f32x4*)(mu + col), m1 = *(const f32x4*)(mu + col + 4);
            float r[8];
#pragma unroll
            for (int e = 0; e < 8; ++e) {
                const unsigned zw = zc[e >> 1], pw = zp[e >> 1];
                const float z = (e & 1) ? __uint_as_float(zw & 0xffff0000u) : __uint_as_float(zw << 16), pz = (e & 1) ? __uint_as_float(pw & 0xffff0000u) : __uint_as_float(pw << 16);
                const float m = e < 4 ? m0[e & 3] : m1[e & 3]; const float s = z + (pz - z) * m;
                r[e] = g < 8 ? 1.0f - 2.0f / (1.0f + __expf(2.0f * s)) : (g < 16 ? s : sigmoidf_(s));
            }
            o.x = cvt_pk_bf16(r[0], r[1]); o.y = cvt_pk_bf16(r[2], r[3]); o.z = cvt_pk_bf16(r[4], r[5]); o.w = cvt_pk_bf16(r[6], r[7]);
        }
        *(u32x4*)(LA + (size_t)t * KL + 8 * g) = o;
    }
}
DI float ret_lg2(int h) { return log1pf(-exp2f(-5.0f - (float)h)) * 1.4426950408889634f; }
DI void ret_kv(const Ctx& c, const bf16_t* ZRET, float* KV) {
    typedef pg8::bf16x8 bf16x8;
    const int w = c.wave, lane = c.lane, fr = lane & 15, fq = lane >> 4, dt = w >> 1, et0 = (w & 1) * 2;
    LAS unsigned char* L = c.lds;
    constexpr int OKT = 0, OVT = 17408;
    for (int u = c.bx; u < 1024; u += c.G) {
        const int bh = u >> 5, n = u & 31, b = bh >> 3, h = bh & 7; const float lg2 = ret_lg2(h);
        const bf16_t* zb = ZRET + ((size_t)b * SEQ + n * 128) * 2048 + h * 64;
#pragma unroll
        for (int x = 0; x < 2; ++x) {
            const int g = c.tid + 512 * x, j = g >> 3, dg = (g & 7) * 8; const bf16_t* p = zb + (size_t)j * 2048 + dg;
            const u32x4 rk = *(const u32x4*)(p + 512), rv = *(const u32x4*)(p + 1024);
            const float dj = exp2f((float)(127 - j) * lg2);
#pragma unroll
            for (int i = 0; i < 8; ++i) {
                const unsigned kw = (rk[i >> 1] >> (16 * (i & 1))) & 0xffffu, vw = (rv[i >> 1] >> (16 * (i & 1))) & 0xffffu;
                *(LAS bf16_t*)(L + OKT + (dg + i) * 272 + j * 2) = f2bf(bf2f((bf16_t)kw) * dj);
                *(LAS bf16_t*)(L + OVT + (dg + i) * 272 + j * 2) = (bf16_t)vw;
            }
        }
        __syncthreads();
        f32x4 sacc[2]; sacc[0] = (f32x4){0.f, 0.f, 0.f, 0.f}; sacc[1] = sacc[0];
#pragma unroll
        for (int ks = 0; ks < 4; ++ks) { const bf16x8 ka = *(const LAS bf16x8*)(L + OKT + (16 * dt + fr) * 272 + (ks * 32 + fq * 8) * 2);
#pragma unroll
            for (int x = 0; x < 2; ++x) { const bf16x8 vb = *(const LAS bf16x8*)(L + OVT + (16 * (et0 + x) + fr) * 272 + (ks * 32 + fq * 8) * 2); sacc[x] = __builtin_amdgcn_mfma_f32_16x16x32_bf16(ka, vb, sacc[x], 0, 0, 0); } }
        float* kvo = KV + (size_t)u * 4096;
#pragma unroll
        for (int x = 0; x < 2; ++x) *(f32x4*)(kvo + (16 * (et0 + x) + fr) * 64 + 16 * dt + fq * 4) = sacc[x];
        __syncthreads();
    }
}
DI void ret_prefix(const Ctx& c, const float* KV, bf16_t* PS) {
    for (int idx = c.gtid; idx < 32 * 4096; idx += c.NGT) {
        const int bh = idx >> 12, e = (idx >> 6) & 63, d = idx & 63; const float cdec = exp2f(128.0f * ret_lg2(bh & 7));
        float st = 0.f;
        float kv[8];
        for (int n0 = 0; n0 < 32; n0 += 8) {
#pragma unroll
            for (int j = 0; j < 8; ++j) kv[j] = KV[(size_t)(bh * 32 + n0 + j) * 4096 + e * 64 + d];
#pragma unroll
            for (int j = 0; j < 8; ++j) { PS[(size_t)(bh * 32 + n0 + j) * 4096 + e * 64 + d] = f2bf(st); st = st * cdec + kv[j]; }
        }
    }
}
DI void ret_out(const Ctx& c, const bf16_t* ZRET, const bf16_t* PS, const float* gn_g, const float* gn_b, bf16_t* MIX) {
    typedef pg8::bf16x8 bf16x8;
    const int w = c.wave, lane = c.lane, fr = lane & 15, fq = lane >> 4, i0 = 16 * w;
    LAS unsigned char* L = c.lds;
    constexpr int OQ = 0, OKS = 18432, OVT = 36864, OP = 54272;
    LAS unsigned char* Pw = L + OP + w * 4352;
    u32x4 rq[2], rk[2], rv[2], rg[2];
    constexpr int OG = 89088;
#define RET_LOAD(u_) do { const int bh_ = (u_) >> 5, n_ = (u_) & 31; const bf16_t* zb_ = ZRET + ((size_t)(bh_ >> 3) * SEQ + n_ * 128) * 2048 + (bh_ & 7) * 64; \
        _Pragma("unroll") for (int x = 0; x < 2; ++x) { const int g = c.tid + 512 * x, j = g >> 3, dg = (g & 7) * 8; const bf16_t* p = zb_ + (size_t)j * 2048 + dg; \
        rq[x] = *(const u32x4*)p; rk[x] = *(const u32x4*)(p + 512); rv[x] = *(const u32x4*)(p + 1024); rg[x] = *(const u32x4*)(p + 1536); } } while (0)
    if (c.bx < 1024) RET_LOAD(c.bx);
    for (int u = c.bx; u < 1024; u += c.G) {
        const int bh = u >> 5, n = u & 31, b = bh >> 3, h = bh & 7; const float lg2 = ret_lg2(h);
#pragma unroll
        for (int x = 0; x < 2; ++x) {
            const int g = c.tid + 512 * x, j = g >> 3, dg = (g & 7) * 8;
            *(LAS u32x4*)(L + OQ + j * 144 + dg * 2) = rq[x]; *(LAS u32x4*)(L + OKS + j * 144 + dg * 2) = rk[x]; *(LAS u32x4*)(L + OG + j * 144 + dg * 2) = rg[x];
#pragma unroll
            for (int i = 0; i < 8; ++i) *(LAS bf16_t*)(L + OVT + (dg + i) * 272 + j * 2) = (bf16_t)((rv[x][i >> 1] >> (16 * (i & 1))) & 0xffffu);
        }
        if (u + c.G < 1024) RET_LOAD(u + c.G);
        const size_t t0 = (size_t)b * SEQ + n * 128 + i0 + fq * 4;
        bf16x8 sb[2][4];
#pragma unroll
        for (int ks = 0; ks < 2; ++ks)
#pragma unroll
            for (int et = 0; et < 4; ++et) sb[ks][et] = *(const bf16x8*)(PS + (size_t)u * 4096 + (16 * et + fr) * 64 + ks * 32 + fq * 8);
        float gg[4], gb[4];
#pragma unroll
        for (int et = 0; et < 4; ++et) { gg[et] = gn_g[h * 64 + 16 * et + fr]; gb[et] = gn_b[h * 64 + 16 * et + fr]; }
        __syncthreads();
        bf16x8 qa[2];
#pragma unroll
        for (int ks = 0; ks < 2; ++ks) qa[ks] = *(const LAS bf16x8*)(L + OQ + (i0 + fr) * 144 + (ks * 32 + fq * 8) * 2);
#pragma unroll
        for (int jt = 0; jt < 8; ++jt) {
            f32x4 sc = (f32x4){0.f, 0.f, 0.f, 0.f};
#pragma unroll
            for (int ks = 0; ks < 2; ++ks) { const bf16x8 kb = *(const LAS bf16x8*)(L + OKS + (16 * jt + fr) * 144 + (ks * 32 + fq * 8) * 2); sc = __builtin_amdgcn_mfma_f32_16x16x32_bf16(qa[ks], kb, sc, 0, 0, 0); }
#pragma unroll
            for (int r = 0; r < 4; ++r) { const int di = (i0 + fq * 4 + r) - (16 * jt + fr); const float pv = di >= 0 ? sc[r] * exp2f((float)di * lg2) : 0.f;
                *(LAS bf16_t*)(Pw + (fq * 4 + r) * 272 + (16 * jt + fr) * 2) = f2bf(pv); }
        }
        f32x4 o[4], cr[4];
#pragma unroll
        for (int et = 0; et < 4; ++et) { o[et] = (f32x4){0.f, 0.f, 0.f, 0.f}; cr[et] = o[et]; }
#pragma unroll
        for (int ks = 0; ks < 4; ++ks) { const bf16x8 pa = *(const LAS bf16x8*)(Pw + fr * 272 + (ks * 32 + fq * 8) * 2);
#pragma unroll
            for (int et = 0; et < 4; ++et) { const bf16x8 vb = *(const LAS bf16x8*)(L + OVT + (16 * et + fr) * 272 + (ks * 32 + fq * 8) * 2); o[et] = __builtin_amdgcn_mfma_f32_16x16x32_bf16(pa, vb, o[et], 0, 0, 0); } }
#pragma unroll
        for (int ks = 0; ks < 2; ++ks)
#pragma unroll
            for (int et = 0; et < 4; ++et) cr[et] = __builtin_amdgcn_mfma_f32_16x16x32_bf16(qa[ks], sb[ks][et], cr[et], 0, 0, 0);
#pragma unroll
        for (int r = 0; r < 4; ++r) {
            const int i = i0 + fq * 4 + r; const float qd = exp2f((float)(i + 1) * lg2);
            float v[4]; float s = 0.f;
#pragma unroll
            for (int et = 0; et < 4; ++et) { v[et] = o[et][r] + cr[et][r] * qd; s += v[et]; }
            const float mean = red16(s) * (1.0f / 64.0f); float q = 0.f;
#pragma unroll
            for (int et = 0; et < 4; ++et) { v[et] -= mean; q += v[et] * v[et]; }
            const float rstd = 1.0f / sqrtf(red16(q) * (1.0f / 64.0f) + 1e-5f);
#pragma unroll
            for (int et = 0; et < 4; ++et) { const float g = bf2f(*(const LAS bf16_t*)(L + OG + i * 144 + (16 * et + fr) * 2));
                *(LAS bf16_t*)(L + OQ + i * 144 + (16 * et + fr) * 2) = f2bf(g * sigmoidf_(g) * (v[et] * rstd * gg[et] + gb[et])); }
        }
        asm volatile("s_waitcnt lgkmcnt(0)" ::: "memory");
#pragma unroll
        for (int x = 0; x < 2; ++x) { const int rr = lane >> 2, ch = (lane & 3) * 2 + x;
            const u32x4 ov = *(const LAS u32x4*)(L + OQ + (i0 + rr) * 144 + ch * 16);
            *(u32x4*)(MIX + ((size_t)b * SEQ + n * 128 + i0 + rr) * D + h * 64 + ch * 8) = ov; }
        __syncthreads();
    }
#undef RET_LOAD
}
struct SideP { const bf16_t* ZRW; const float* LW; const bf16_t* LA2; const bf16_t* LG; const float* mu; const float* k_k; const float* k_a; const float* r_k; const float* gn_g; const float* gn_b; bf16_t* MIX; };
DI void rounds_side(int bh, int tl_first, int tstep, int lane, int p, const SideP& P, float* SC, const float* YB) {
    const int b = bh >> 3, h = bh & 7, hc = h * 64 + lane;
    const float mu_r = P.mu[hc], mu_k = P.mu[512 + hc], mu_v = P.mu[1024 + hc], kkc = P.k_k[hc], kac = P.k_a[hc], rkc = P.r_k[hc], gg = P.gn_g[hc], gb = P.gn_b[hc];
    const bool do_post = p >= 2, do_prep = p < NR;
    for (int tl0 = tl_first; tl0 < TR; tl0 += 4 * tstep) {
        float pr[4], pk[4], pv[4], py[4], pg[4];
        float z0[4], z1[4], z2[4], q0[4], q1[4], q2[4], lw[4], la[4];
        if (do_post) {
#pragma unroll
            for (int j = 0; j < 4; ++j) { const int tl = tl0 + tstep * j; if (tl >= TR) continue; const size_t t = (size_t)b * SEQ + (p - 2) * TR + tl; const float* rec = SC + ((size_t)bh * TR + tl) * REC + lane;
                pr[j] = rec[0]; pk[j] = rec[128]; pv[j] = rec[320]; py[j] = YB[((size_t)bh * TR + tl) * 64 + lane]; pg[j] = bf2f(P.LG[t * 512 + hc]); }
        }
        if (do_prep) {
#pragma unroll
            for (int j = 0; j < 4; ++j) { if (tl0 + tstep * j >= TR) continue; const int tin = p * TR + tl0 + tstep * j; const size_t t = (size_t)b * SEQ + tin; const bf16_t* zr = P.ZRW + t * 2048 + hc;
                z0[j] = bf2f(zr[0]); z1[j] = bf2f(zr[512]); z2[j] = bf2f(zr[1024]);
                if (tin) { q0[j] = bf2f(zr[-2048]); q1[j] = bf2f(zr[512 - 2048]); q2[j] = bf2f(zr[1024 - 2048]); } else { q0[j] = 0.f; q1[j] = 0.f; q2[j] = 0.f; }
                lw[j] = P.LW[t * 512 + hc]; la[j] = bf2f(P.LA2[t * 512 + hc]); }
        }
        if (do_post) {
#pragma unroll
            for (int j = 0; j < 4; ++j) { const int tl = tl0 + tstep * j; if (tl >= TR) continue; const size_t t = (size_t)b * SEQ + (p - 2) * TR + tl;
                const float mean = wave_sum(py[j]) * (1.0f / 64.0f); const float dv = py[j] - mean; const float var = wave_sum(dv * dv) * (1.0f / 64.0f);
                const float yn = dv * (1.0f / sqrtf(var + 64e-5f)) * gg + gb; const float bonus = wave_sum(pr[j] * pk[j] * rkc) * pv[j];
                P.MIX[t * D + 512 + hc] = f2bf((yn + bonus) * pg[j]); }
        }
        if (do_prep) {
#pragma unroll
            for (int j = 0; j < 4; ++j) { const int tl = tl0 + tstep * j; if (tl >= TR) continue;
                const float r = z0[j] + (q0[j] - z0[j]) * mu_r, kr = z1[j] + (q1[j] - z1[j]) * mu_k, v = z2[j] + (q2[j] - z2[j]) * mu_v;
                const float w = decay_from_lora(lw[j]), a = sigmoidf_(la[j]);
                float kk = kr * kkc; const float n2 = wave_sum(kk * kk); kk = kk / fmaxf(sqrtf(n2), 1e-12f);
                float* rec = SC + ((size_t)bh * TR + tl) * REC + lane;
                rec[0] = r; rec[64] = w; rec[128] = kr * (1.0f + (a - 1.0f) * kac); rec[192] = kk; rec[256] = -(kk * a); rec[320] = v; }
        }
    }
}
struct StepIn { f32x4 r, w, k, kk, b; float v; };
DI float fma_(float a, float b, float c) { float d; asm("v_fma_f32 %0, %1, %2, %3" : "=v"(d) : "v"(a), "v"(b), "v"(c)); return d; }
DI float nfma_(float a, float b, float c) { float d; asm("v_fma_f32 %0, -%1, %2, %3" : "=v"(d) : "v"(a), "v"(b), "v"(c)); return d; }
DI float mul_(float a, float b) { float d; asm("v_mul_f32 %0, %1, %2" : "=v"(d) : "v"(a), "v"(b)); return d; }
#define RING_NB 4
DI unsigned lds_ld(volatile LAS unsigned* p) { return __hip_atomic_load((LAS unsigned*)p, __ATOMIC_RELAXED, __HIP_MEMORY_SCOPE_WORKGROUP); }
DI void lds_st(volatile LAS unsigned* p, unsigned v) { __hip_atomic_store((LAS unsigned*)p, v, __ATOMIC_RELAXED, __HIP_MEMORY_SCOPE_WORKGROUP); }
DI int scan_bh(int bx) { return (bx & 7) * 4 + (bx >> 6); }
DI void scan_loader(const Ctx& c, int round, const float* SC, volatile LAS unsigned* ctl) {
    const float* rec0 = SC + (size_t)scan_bh(c.bx) * TR * REC;
    const unsigned gb0 = (unsigned)round * (TR / 16);
    for (int blk = 0; blk < TR / 16; ++blk) {
        const unsigned gb = gb0 + blk;
        if (gb >= RING_NB) { while (min(lds_ld(ctl + 1), lds_ld(ctl + 2)) + RING_NB <= gb) __builtin_amdgcn_s_sleep(1); }
        asm volatile("" ::: "memory");
        LAS unsigned char* dst = c.lds + (gb % RING_NB) * 24576;
#pragma unroll
        for (int q = 0; q < 24; ++q)
            __builtin_amdgcn_global_load_lds((const unsigned*)(rec0 + (size_t)blk * 16 * REC + (q * 64 + c.lane) * 4), (LAS unsigned*)(dst + q * 1024), 16, 0, 0);
        if (blk > 0) { asm volatile("s_waitcnt vmcnt(24)" ::: "memory"); lds_st(ctl, gb); }
    }
    asm volatile("s_waitcnt vmcnt(0)" ::: "memory"); lds_st(ctl, gb0 + TR / 16);
}
DI void scan_round(const Ctx& c, int sw, int round, float* YB, float* ST, volatile LAS unsigned* ctl, bool keep = true) {
    const int bh = scan_bh(c.bx), rg = ((c.bx >> 3) & 7) * 2 + sw, kq = c.lane & 15, row = rg * 4 + (c.lane >> 4);
    float* y0 = YB + (size_t)bh * TR * 64;
    float* stp = ST + ((size_t)bh * 64 + row) * 64 + kq * 4;
    f32x4 S = (f32x4){0.f, 0.f, 0.f, 0.f};
    if (round) S = *(const f32x4*)stp;
    const unsigned gb0 = (unsigned)round * (TR / 16);
#define SCAN_LD(dst, s) do { const LAS unsigned char* ps_ = p + (s) * 1536; dst.r = *(const LAS f32x4*)(ps_ + kq * 16); dst.w = *(const LAS f32x4*)(ps_ + 256 + kq * 16); dst.k = *(const LAS f32x4*)(ps_ + 512 + kq * 16); \
        dst.kk = *(const LAS f32x4*)(ps_ + 768 + kq * 16); dst.b = *(const LAS f32x4*)(ps_ + 1024 + kq * 16); dst.v = *(const LAS float*)(ps_ + 1280 + row * 4); } while (0)
    unsigned seen = lds_ld(ctl);
    for (int blk = 0; blk < TR / 16; ++blk) {
        const unsigned gb = gb0 + blk;
        while (seen <= gb) { __builtin_amdgcn_s_sleep(1); seen = lds_ld(ctl); }
        asm volatile("" ::: "memory");
        const LAS unsigned char* p = c.lds + (gb % RING_NB) * 24576;
        float yp[16];
        StepIn cur, nxt, nx2; SCAN_LD(cur, 0); SCAN_LD(nxt, 1);
        f32x4 rprev = cur.r;
#pragma unroll
        for (int s = 0; s < 16; ++s) {
            if (s < 14) SCAN_LD(nx2, s + 2);
            if (s == 8) seen = lds_ld(ctl);
            float sa; { float a0 = mul_(S[0], cur.kk[0]), a1 = mul_(S[2], cur.kk[2]); a0 = fma_(S[1], cur.kk[1], a0); a1 = fma_(S[3], cur.kk[3], a1); asm("v_add_f32 %0, %1, %2" : "=v"(sa) : "v"(a0), "v"(a1)); }
            if (s > 0) { float y = S[0] * rprev[0]; y = fmaf(S[1], rprev[1], y); y = fmaf(S[2], rprev[2], y); y = fmaf(S[3], rprev[3], y); yp[s - 1] = y; }
            const f32x4 T = S * cur.w + cur.k * cur.v;
            sa = red16(sa);
            S = T + cur.b * sa;
            rprev = cur.r;
            if (s < 15) cur = nxt;
            if (s < 14) nxt = nx2;
        }
        { float y = S[0] * rprev[0]; y = fmaf(S[1], rprev[1], y); y = fmaf(S[2], rprev[2], y); y = fmaf(S[3], rprev[3], y); yp[15] = y; }
        float yk;
        {
            const bool b3 = (kq & 8) != 0, b2 = (kq & 4) != 0, b1 = (kq & 2) != 0, b0 = (kq & 1) != 0;
            float q8[8], q4[4], q2[2];
#pragma unroll
            for (int j = 0; j < 8; ++j) { const float keep = b3 ? yp[j + 8] : yp[j], send = b3 ? yp[j] : yp[j + 8]; q8[j] = keep + dpp_f<0x128>(send); }
#pragma unroll
            for (int j = 0; j < 4; ++j) { const float keep = b2 ? q8[j + 4] : q8[j], send = b2 ? q8[j] : q8[j + 4]; q4[j] = keep + dpp_f<0x141>(send); }
#pragma unroll
            for (int j = 0; j < 2; ++j) { const float keep = b1 ? q4[j + 2] : q4[j], send = b1 ? q4[j] : q4[j + 2]; q2[j] = keep + dpp_f<0x4E>(send); }
            { const float keep = b0 ? q2[1] : q2[0], send = b0 ? q2[0] : q2[1]; yk = keep + dpp_f<0xB1>(send); }
        }
        asm volatile("s_waitcnt lgkmcnt(0)" ::: "memory");
        lds_st(ctl + 1 + sw, gb + 1);
        y0[(size_t)(blk * 16 + kq) * 64 + row] = yk;
    }
#undef SCAN_LD
    if (keep) *(f32x4*)stp = S;
}

#define XB_TMO      128
#define XB_XCNT(j)  (256  + 64 * (j))
#define XB_XSUB(j)  (1280 + 64 * (j))
#define XB_XGEN(j)  (2304 + 64 * (j))
#define XB_TOP      3328
#define XB_TOPGEN   3392
#define XCD_BAR_WORDS 3456
#define XB_SPIN_CAP (1u << 18)

__device__ __forceinline__ unsigned xb_ld(unsigned* p)              { return __hip_atomic_load(p, __ATOMIC_RELAXED, __HIP_MEMORY_SCOPE_AGENT); }
__device__ __forceinline__ unsigned xb_add(unsigned* p, unsigned v) { return __hip_atomic_fetch_add(p, v, __ATOMIC_RELAXED, __HIP_MEMORY_SCOPE_AGENT); }
__device__ __forceinline__ unsigned xb_xcc_id() { return (unsigned)__builtin_amdgcn_s_getreg((3 << 11) | 20) & 0xFu; }
#define XB_SPIN(cond, bar) do { unsigned _sp = 0; while (cond) { __builtin_amdgcn_s_sleep(1); \
    if ((++_sp & 255u) == 0u) { if (xb_ld(&(bar)[XB_TMO])) break; if (_sp > XB_SPIN_CAP) { atomicAdd(&(bar)[XB_TMO], 1u); break; } } } } while (0)

struct XcdBarrier {
    unsigned* bar; unsigned x;
    volatile LAS unsigned* st;
};

__device__ __forceinline__ XcdBarrier xcd_barrier_post(unsigned* bar, volatile LAS unsigned* st) {
    XcdBarrier b; b.bar = bar; b.x = xb_xcc_id(); b.st = st;
    if (threadIdx.x == 0) (void)xb_add(&bar[XB_XCNT(b.x)], 1u);
    return b;
}
__device__ __forceinline__ void xcd_barrier_complete(unsigned* bar, unsigned x, unsigned& nloc, unsigned& nx) {
    const unsigned G = gridDim.x * gridDim.y * gridDim.z;
    unsigned sum, cnt, mine, sp = 0u;
    for (;;) {
        sum = 0u; cnt = 0u; mine = 0u;
#pragma unroll
        for (unsigned j = 0; j < 16; ++j) { const unsigned c = xb_ld(&bar[XB_XCNT(j)]); sum += c; cnt += (c > 0u) ? 1u : 0u; mine = (j == x) ? c : mine; }
        if (sum == G) break;
        __builtin_amdgcn_s_sleep(1);
        if ((++sp & 255u) == 0u) { if (xb_ld(&bar[XB_TMO])) break; if (sp > XB_SPIN_CAP) { atomicAdd(&bar[XB_TMO], 1u); break; } }
    }
    nloc = mine > 0u ? mine : 1u; nx = cnt > 0u ? cnt : 1u;
}

__device__ __forceinline__ void xcd_barrier(const XcdBarrier& b) {
    asm volatile("s_waitcnt vmcnt(0)" ::: "memory");
    __syncthreads();
    if (threadIdx.x == 0) {
        unsigned* bar = b.bar;
        __builtin_amdgcn_s_waitcnt(0);
        unsigned nloc = b.st[0], nx = b.st[1];
        if (nloc == 0u) { xcd_barrier_complete(bar, b.x, nloc, nx); b.st[0] = nloc; b.st[1] = nx; }
        const unsigned old = xb_add(&bar[XB_XSUB(b.x)], 1u);
        const unsigned gen = old / nloc;
        if (old + 1u == (gen + 1u) * nloc) {
            __builtin_amdgcn_fence(__ATOMIC_RELEASE, "agent");
            asm volatile("s_waitcnt vmcnt(0)" ::: "memory");
            const unsigned og = xb_add(&bar[XB_TOP], 1u);
            const unsigned tg = og / nx;
            if (og + 1u == (tg + 1u) * nx) xb_add(&bar[XB_TOPGEN], 1u);
            else XB_SPIN(xb_ld(&bar[XB_TOPGEN]) == tg, bar);
            __builtin_amdgcn_fence(__ATOMIC_ACQUIRE, "agent");
            xb_add(&bar[XB_XGEN(b.x)], 1u);
            asm volatile("s_waitcnt vmcnt(0)" ::: "memory");
        } else {
            XB_SPIN(xb_ld(&bar[XB_XGEN(b.x)]) == gen, bar);
            __builtin_amdgcn_fence(__ATOMIC_ACQUIRE, "agent");
            asm volatile("s_waitcnt vmcnt(0)" ::: "memory");
        }
    }
    __syncthreads();
}

struct Args { const float* in[30]; float* out; unsigned char* ws; int ph_lo, ph_hi; };
enum { I_X = 0, I_P, I_F1GU, I_F1D, I_LN1G, I_LN1B, I_WIN, I_RGNG, I_RGNB, I_MU, I_W0, I_WUP, I_A0, I_AUP, I_GUP, I_KK, I_KA, I_RK, I_WGNG, I_WGNB, I_WOUT, I_LN2G, I_LN2B,
       I_F2GU, I_F2D, I_LN3G, I_LN3B, I_PPROJ, I_PGATE, I_PBIAS };

#define CAS __attribute__((address_space(4)))
#define PHASE_BEGIN(k) if (ph_lo <= (k) && (k) < ph_hi) { \
        int tid_ = threadIdx.x; asm volatile("" : "+v"(tid_)); \
        Ctx c; c.lds = (LAS unsigned char*)lds_raw; c.tid = tid_; c.lane = c.tid & 63; c.wave = __builtin_amdgcn_readfirstlane(c.tid >> 6); \
        c.bx = blockIdx.x; c.G = gridDim.x; c.gw = c.bx * 8 + c.wave; c.NGW = c.G * 8; c.gtid = c.bx * 512 + c.tid; c.NGT = c.G * 512; \
        const CAS Args* ap = (const CAS Args*)__builtin_amdgcn_kernarg_segment_ptr(); asm volatile("" : "+s"(ap)); const CAS Args& a = *ap; unsigned char* ws = a.ws; (void)ws;
#define PHASE_END(k) if ((k) + 1 < ph_hi) xcd_barrier(bar); }
#define P_(T, name, off) T* name = (T*)(ws + (off))

#define GEMM_GU(Aptr, statp, c1p, c2p) do { P_(bf16_t, Wgu_t, WS_WGU); P_(bf16_t, H, WS_A); \
        pg8::Gemm g{Aptr, Wgu_t, M, NGU, D}; pg8::StaticOrder S; S.init(M, NGU, c.G, c.bx); EpiGU E{H, statp, c1p, c2p}; \
        pg8::gemm_phase<EpiGU, pg8::StaticOrder, PG_ALIGN, true>(c.lds, g, S, E, c.tid); } while (0)
#define GEMM_RES(Aptr, Wptr, Kdim, Xraw, Yio, YBp, stat_out, ln_stat, lng, lnb, scale) do { \
        pg8::Gemm g{Aptr, Wptr, M, D, Kdim}; pg8::StaticOrder S; S.init(M, D, c.G, c.bx); EpiRes E{Xraw, Yio, YBp, stat_out, ln_stat, lng, lnb, scale}; \
        pg8::gemm_phase<EpiRes, pg8::StaticOrder, PG_ALIGN, true>(c.lds, g, S, E, c.tid); } while (0)
DI void ln_tail(const Ctx& c, int inst, const float* Y, const float* g, const float* b, float* XF, bf16_t* XB, unsigned* cnt_base) {
    pg8::StaticOrder S; S.init(M, D, c.G, c.bx); pg8::Unit u;
    if (!S.next(0, u)) return;
    unsigned* cnt = cnt_base + inst * 64 + u.pm;
    asm volatile("s_waitcnt vmcnt(0)" ::: "memory");
    __syncthreads();
    if (c.tid == 0) {
        __builtin_amdgcn_fence(__ATOMIC_RELEASE, "agent");
        asm volatile("s_waitcnt vmcnt(0)" ::: "memory");
        __hip_atomic_fetch_add(cnt, 1u, __ATOMIC_RELAXED, __HIP_MEMORY_SCOPE_AGENT);
        unsigned sp = 0;
        while (__hip_atomic_load(cnt, __ATOMIC_RELAXED, __HIP_MEMORY_SCOPE_AGENT) < 4u) { __builtin_amdgcn_s_sleep(1); if (++sp > (1u << 22)) break; }
        __builtin_amdgcn_fence(__ATOMIC_ACQUIRE, "agent");
        asm volatile("s_waitcnt vmcnt(0)" ::: "memory");
    }
    __syncthreads();
    const int lane = c.lane;
    const f32x4 g0 = ((const f32x4*)g)[lane], g1 = ((const f32x4*)g)[lane + 64], g2 = ((const f32x4*)g)[lane + 128], g3 = ((const f32x4*)g)[lane + 192];
    const f32x4 b0 = ((const f32x4*)b)[lane], b1 = ((const f32x4*)b)[lane + 64], b2 = ((const f32x4*)b)[lane + 128], b3 = ((const f32x4*)b)[lane + 192];
    for (int rr = c.wave; rr < 64; rr += 8) {
        const int m = u.pm * 256 + u.pn * 64 + rr;
        const f32x4* yr = (const f32x4*)(Y + (size_t)m * D) + lane;
        f32x4 v0 = yr[0], v1 = yr[64], v2 = yr[128], v3 = yr[192];
        float sm = (v0[0] + v0[1] + v0[2] + v0[3]) + (v1[0] + v1[1] + v1[2] + v1[3]) + (v2[0] + v2[1] + v2[2] + v2[3]) + (v3[0] + v3[1] + v3[2] + v3[3]);
        const float mean = wave_sum(sm) * (1.0f / D);
        v0 = v0 - mean; v1 = v1 - mean; v2 = v2 - mean; v3 = v3 - mean;
        float q = (v0[0] * v0[0] + v0[1] * v0[1] + v0[2] * v0[2] + v0[3] * v0[3]) + (v1[0] * v1[0] + v1[1] * v1[1] + v1[2] * v1[2] + v1[3] * v1[3])
                + (v2[0] * v2[0] + v2[1] * v2[1] + v2[2] * v2[2] + v2[3] * v2[3]) + (v3[0] * v3[0] + v3[1] * v3[1] + v3[2] * v3[2] + v3[3] * v3[3]);
        const float rstd = 1.0f / sqrtf(wave_sum(q) * (1.0f / D) + 1e-5f);
        v0 = v0 * rstd * g0 + b0; v1 = v1 * rstd * g1 + b1; v2 = v2 * rstd * g2 + b2; v3 = v3 * rstd * g3 + b3;
        f32x4* xo = (f32x4*)(XF + (size_t)m * D) + lane; xo[0] = v0; xo[64] = v1; xo[128] = v2; xo[192] = v3;
        u32x2* bo = (u32x2*)(XB + (size_t)m * D) + lane; u32x2 o;
        o.x = cvt_pk_bf16(v0[0], v0[1]); o.y = cvt_pk_bf16(v0[2], v0[3]); bo[0] = o;
        o.x = cvt_pk_bf16(v1[0], v1[1]); o.y = cvt_pk_bf16(v1[2], v1[3]); bo[64] = o;
        o.x = cvt_pk_bf16(v2[0], v2[1]); o.y = cvt_pk_bf16(v2[2], v2[3]); bo[128] = o;
        o.x = cvt_pk_bf16(v3[0], v3[1]); o.y = cvt_pk_bf16(v3[2], v3[3]); bo[192] = o;
    }
}
#define LN_TAIL(inst, gi) do { P_(float, Yt, WS_B); P_(bf16_t, XBt, WS_XB); ln_tail(c, inst, Yt, a.in[gi], a.in[(gi) + 1], a.out, XBt, (unsigned*)(ws + 14336)); } while (0)
#define LN_ROWS(gi) do { P_(float, Y, WS_B); P_(bf16_t, XB, WS_XB); layer_norm_rows(c, Y, a.in[gi], a.in[(gi) + 1], a.out, XB); if (DUP_MISC > 1) layer_norm_rows(c, Y, a.in[gi], a.in[(gi) + 1], a.out, XB); } while (0)

__global__ void __launch_bounds__(512, 2) mk_fwd(Args a_kernarg) {
    extern __shared__ __attribute__((aligned(16))) unsigned char lds_raw[];
    cg::grid_group grid = cg::this_grid();
    const int ph_lo = ((const CAS Args*)__builtin_amdgcn_kernarg_segment_ptr())->ph_lo, ph_hi = ((const CAS Args*)__builtin_amdgcn_kernarg_segment_ptr())->ph_hi;
    if (threadIdx.x < 32) ((volatile LAS unsigned*)((LAS unsigned char*)lds_raw + 135 * 1024))[threadIdx.x] = 0u;
    __syncthreads();
    XcdBarrier bar; bar.bar = nullptr; bar.x = 0; bar.st = nullptr;
    if (ph_hi - ph_lo > 1) bar = xcd_barrier_post((unsigned*)((const CAS Args*)__builtin_amdgcn_kernarg_segment_ptr())->ws, (volatile LAS unsigned*)((LAS unsigned char*)lds_raw + 135 * 1024));
    if (ph_hi > NPH) grid.sync();
    constexpr int PH_ROUND0 = 8, PH_WOUT = 8 + NR + 2;

    PHASE_BEGIN(0)
        P_(bf16_t, Wgu_t, WS_WGU); P_(bf16_t, Wd_t, WS_WD); P_(bf16_t, XB, WS_XB);
        { LAS float* scr0 = (LAS float*)(c.lds + c.wave * 8448);
          for (int it = c.gw; it < 2816; it += c.NGW) { const int kb = it / 176, nb = it % 176; transpose_item(a.in[I_F1GU], NGU, Wgu_t, D, gu_dst_row(32 * nb), 64 * kb, 32 * nb, scr0, c.lane); } }
        for (int i = c.gtid; i < (int)((WS_ZERO_BYTES - WS_C1WIN) / 16); i += c.NGT) ((u32x4*)(ws + WS_C1WIN))[i] = (u32x4){0u, 0u, 0u, 0u};
        cvt_rows_bf16(c, a.in[I_X], XB, (size_t)M * D / 4);
    PHASE_END(0)
#define RSTAT(i) ((float*)(ws + WS_RSTAT) + (size_t)(i) * 2 * M)
    PHASE_BEGIN(1) {
        { P_(bf16_t, XB, WS_XB); GEMM_GU(XB, (const float*)nullptr, (const float*)nullptr, (const float*)nullptr); }
        if (c.bx >= c.G / 2) {
            P_(bf16_t, Win_t, WS_WIN); P_(bf16_t, Wlora_t, WS_WLORA); P_(bf16_t, Wout_t, WS_WOUT); P_(float, CS, WS_CS);
            const int gw2 = (c.bx - c.G / 2) * 8 + c.wave, ngw2 = (c.G / 2) * 8, gt2 = (c.bx - c.G / 2) * 512 + c.tid, ngt2 = (c.G / 2) * 512;
            LAS float* scr = (LAS float*)(c.lds + c.wave * 8448);
            { P_(bf16_t, Wd_t, WS_WD); for (int it = gw2; it < 1408; it += ngw2) { const int kb = it / 32, nb = it % 32; transpose_item(a.in[I_F1D], D, Wd_t, FF, 32 * nb, 64 * kb, 32 * nb, scr, c.lane); } }
            for (int it = gw2; it < 1936 + 512; it += ngw2) {
                if (it < 1936) { const int kb = it / 121, nb = it % 121; transpose_item(a.in[I_WIN], NIN, Win_t, D, win_dst_row(32 * nb), 64 * kb, 32 * nb, scr, c.lane, a.in[I_LN1G], a.in[I_LN1B], (float*)(ws + WS_C1WIN), (float*)(ws + WS_C2WIN)); }
                else { const int r = it - 1936, kb = r / 32, nb = r % 32; transpose_item(a.in[I_WOUT], D, Wout_t, D, 32 * nb, 64 * kb, 32 * nb, scr, c.lane); }
            }
            for (int i = gt2; i < (NINP - NIN) * D / 8; i += ngt2) ((u32x4*)(Win_t + (size_t)NIN * D))[i] = (u32x4){0u, 0u, 0u, 0u};
            for (int i = gt2; i < NL * KL; i += ngt2) {
                const int n = i / KL, k = i % KL; float v = 0.f;
                if (n < 512) { if (k < 64) v = a.in[I_WUP][k * 512 + n]; }
                else if (n < 1024) { if (k >= 64 && k < 128) v = a.in[I_AUP][(k - 64) * 512 + (n - 512)]; }
                else { if (k >= 128 && k < 288) v = a.in[I_GUP][(k - 128) * 512 + (n - 1024)]; }
                Wlora_t[i] = f2bf(v);
            }
            for (int i = gt2; i < SEQ * 32; i += ngt2) {
                const int pos = i >> 5, f = i & 31; double pw = 1.0; for (int j = 0; j < f; ++j) pw *= 0.7498942093324559;
                const float invf = (float)pw; const float ang = (float)pos * invf;
                double r = (double)ang; r -= 6.283185307179586 * __builtin_rint(r * 0.15915494309189535); const double x = r * 0.25, x2 = x * x;
                double sn = x * (1.0 + x2 * (-1.0 / 6 + x2 * (1.0 / 120 + x2 * (-1.0 / 5040 + x2 * (1.0 / 362880 + x2 * (-1.0 / 39916800 + x2 * (1.0 / 6227020800.0)))))));
                double cn = 1.0 + x2 * (-0.5 + x2 * (1.0 / 24 + x2 * (-1.0 / 720 + x2 * (1.0 / 40320 + x2 * (-1.0 / 3628800 + x2 * (1.0 / 479001600.0 + x2 * (-1.0 / 87178291200.0)))))));
                double s2 = 2.0 * sn * cn, c2 = 1.0 - 2.0 * sn * sn; sn = 2.0 * s2 * c2; cn = 1.0 - 2.0 * s2 * s2;
                CS[2 * i] = (float)cn; CS[2 * i + 1] = (float)sn;
            }
        }
    } PHASE_END(1)
    PHASE_BEGIN(2) { P_(bf16_t, H, WS_A); P_(bf16_t, Wd_t, WS_WD); P_(bf16_t, XB, WS_XB);
        GEMM_RES(H, Wd_t, FF, a.in[I_X], a.out, XB, RSTAT(0), (const float*)nullptr, (const float*)nullptr, (const float*)nullptr, 0.5f); } PHASE_END(2)
    PHASE_BEGIN(3) {
        P_(bf16_t, XB, WS_XB); P_(bf16_t, Win_t, WS_WIN); P_(bf16_t, ZRET, WS_A); P_(bf16_t, ZRW, WS_B); P_(float, CS, WS_CS);
        pg8::Gemm g{XB, Win_t, M, NINP, D}; pg8::StaticOrder S; S.init(M, NINP, c.G, c.bx); EpiWin E{ZRET, ZRW, CS, RSTAT(0), (const float*)(ws + WS_C1WIN), (const float*)(ws + WS_C2WIN)};
        pg8::gemm_phase<EpiWin, pg8::StaticOrder, PG_ALIGN, true>(c.lds, g, S, E, c.tid);
    } PHASE_END(3)
    PHASE_BEGIN(4) {
        P_(bf16_t, ZRET, WS_A); P_(bf16_t, ZRW, WS_B); P_(bf16_t, LA, WS_A + 64 * MiB); P_(bf16_t, MIX, WS_XB);
        prep_lora_a(c, ZRW, a.in[I_MU], LA);
#ifdef DUP_PREPA
        prep_lora_a(c, ZRW, a.in[I_MU], LA);
#endif
        { P_(float, KV, WS_SC); ret_kv(c, ZRET, KV); }
    } PHASE_END(4)
    PHASE_BEGIN(5) { P_(float, KV, WS_SC); P_(bf16_t, PS, WS_PB); ret_prefix(c, KV, PS); } PHASE_END(5)
    PHASE_BEGIN(6) { P_(bf16_t, ZRET, WS_A); P_(bf16_t, PS, WS_PB); P_(bf16_t, MIXr, WS_XB); ret_out(c, ZRET, PS, a.in[I_RGNG], a.in[I_RGNB], MIXr); } PHASE_END(6)
    PHASE_BEGIN(7) {
        P_(bf16_t, LA, WS_A + 64 * MiB); P_(bf16_t, Wlora_t, WS_WLORA); P_(float, LW, WS_A); P_(bf16_t, LA2, WS_A + 32 * MiB); P_(bf16_t, LG, WS_A + 48 * MiB);
        int kdim = KL; asm volatile("" : "+s"(kdim)); pg8::Gemm g{LA, Wlora_t, M, NL, kdim}; pg8::StaticOrder S; S.init(M, NL, c.G, c.bx); EpiLora E{LW, LA2, LG, a.in[I_W0], a.in[I_A0]};
        pg8::gemm_phase<EpiLora, pg8::StaticOrder, PG_ALIGN, true>(c.lds, g, S, E, c.tid);
#if DUP_GEMM > 1
        __syncthreads(); pg8::gemm_phase<EpiLora, pg8::StaticOrder, PG_ALIGN, true>(c.lds, g, S, E, c.tid);
#endif
    } PHASE_END(7)
    for (int p = 0; p < NR + 2; ++p) {
        PHASE_BEGIN(PH_ROUND0 + p) {
            P_(float, ST, WS_ST); P_(float, YBA, WS_PB);
            float* SCb[2] = {(float*)(ws + WS_SC), (float*)(ws + WS_A + 64 * MiB)};
            float* SCw = (p & 1) ? SCb[1] : SCb[0]; float* SCr = (p & 1) ? SCb[0] : SCb[1];
            float* YBw = YBA + (size_t)((p & 1) ^ 1) * (32 * TR * 64); float* YBr = YBA + (size_t)(p & 1) * (32 * TR * 64);
            volatile LAS unsigned* ctl = (volatile LAS unsigned*)(c.lds + 135 * 1024 + 64);
            if ((p == 0 || p == NR + 1) && (c.wave == 0 || c.wave == 2 || c.wave == 5)) {
                P_(bf16_t, Wgu_t, WS_WGU); P_(bf16_t, Wd_t, WS_WD);
                LAS float* scr = (LAS float*)(c.lds + c.wave * 8448);
                const int widx = c.bx * 3 + (c.wave == 0 ? 0 : (c.wave == 2 ? 1 : 2)), lo_it = p == 0 ? 0 : 2112, hi_it = p == 0 ? 2112 : 4224;
                for (int it = lo_it + widx; it < hi_it; it += c.G * 3) {
                    if (it < 2816) { const int kb = it / 176, nb = it % 176; transpose_item(a.in[I_F2GU], NGU, Wgu_t, D, gu_dst_row(32 * nb), 64 * kb, 32 * nb, scr, c.lane, a.in[I_LN2G], a.in[I_LN2B], (float*)(ws + WS_C1GU), (float*)(ws + WS_C2GU)); }
                    else { const int r = it - 2816, kb = r / 32, nb = r % 32; transpose_item(a.in[I_F2D], D, Wd_t, FF, 32 * nb, 64 * kb, 32 * nb, scr, c.lane); }
                }
            } else if (c.wave == 0 || c.wave == 5) {
#ifdef DUP_SCAN
                if (p >= 1 && p <= NR) scan_round(c, c.wave ? 1 : 0, p - 1, YBw, ST, ctl, false);
#endif
                __builtin_amdgcn_s_setprio(3);
                if (p >= 1 && p <= NR) scan_round(c, c.wave ? 1 : 0, p - 1, YBw, ST, ctl);
                __builtin_amdgcn_s_setprio(0);
            } else if (c.wave == 2) {
                if (p >= 1 && p <= NR) scan_loader(c, p - 1, SCr, ctl);
            } else {
                P_(bf16_t, ZRW, WS_B); P_(float, LW, WS_A); P_(bf16_t, LA2, WS_A + 32 * MiB); P_(bf16_t, LG, WS_A + 48 * MiB); P_(bf16_t, MIX, WS_XB);
                const int sidx = c.wave == 1 ? 0 : (c.wave == 3 ? 1 : (c.wave == 4 ? 2 : c.wave - 3));
                const int lw = (c.bx >> 3) * 5 + sidx;
                const int sbh = (c.bx & 7) * 4 + (lw & 3), tl_first = lw >> 2, tstep = (c.G >> 3) * 5 / 4;
                SideP SP{ZRW, LW, LA2, LG, a.in[I_MU], a.in[I_KK], a.in[I_KA], a.in[I_RK], a.in[I_WGNG], a.in[I_WGNB], MIX};
                rounds_side(sbh, tl_first, tstep, c.lane, p, SP, SCw, YBr);
            }
        } PHASE_END(PH_ROUND0 + p)
    }
    PHASE_BEGIN(PH_WOUT) {
        { P_(bf16_t, MIX, WS_XB); P_(bf16_t, Wout_t, WS_WOUT); P_(bf16_t, YB2, WS_B);
          GEMM_RES(MIX, Wout_t, D, (const float*)nullptr, a.out, YB2, RSTAT(1), (const float*)RSTAT(0), a.in[I_LN1G], a.in[I_LN1B], 1.0f); }
        { P_(bf16_t, Wpp_t, WS_WPP); P_(bf16_t, PB, WS_PB); LAS float* scr = (LAS float*)(c.lds + c.wave * 8448);
          for (int it = c.gw; it < 128; it += c.NGW) { const int kb = it / 32, nb = it % 32; transpose_item(a.in[I_PPROJ], D, Wpp_t, DP, 32 * nb, 64 * kb, 32 * nb, scr, c.lane); }
          cvt_rows_bf16(c, a.in[I_P], PB, (size_t)M * DP / 4); }
    } PHASE_END(PH_WOUT)
    PHASE_BEGIN(PH_WOUT + 1) {
        { P_(bf16_t, YB2, WS_B); GEMM_GU(YB2, (const float*)RSTAT(1), (const float*)(ws + WS_C1GU), (const float*)(ws + WS_C2GU)); }
        if (c.bx >= c.G / 2) {
            P_(bf16_t, Wpg_t, WS_WPG); P_(bf16_t, Wpp_t, WS_WPP); P_(bf16_t, PB, WS_PB); P_(bf16_t, PROJ, WS_XB);
            const int gw2 = (c.bx - c.G / 2) * 8 + c.wave, ngw2 = (c.G / 2) * 8;
            LAS float* scr = (LAS float*)(c.lds + c.wave * 8448);
            for (int it = gw2; it < 512; it += ngw2) { const int kb = it / 32, nb = it % 32; transpose_item(a.in[I_PGATE], D, Wpg_t, D, 32 * nb, 64 * kb, 32 * nb, scr, c.lane, a.in[I_LN3G], a.in[I_LN3B], (float*)(ws + WS_C1PG), (float*)(ws + WS_C2PG)); }
            __syncthreads();
            { int kdim = DP; asm volatile("" : "+s"(kdim)); const int t3 = launder_v(c.tid); pg8::Gemm g{PB, Wpp_t, M, D, kdim}; pg8::StaticOrder S; S.init(M, D, c.G / 2, c.bx - c.G / 2); EpiProj E{PROJ};
              pg8::gemm_phase<EpiProj, pg8::StaticOrder, PG_ALIGN, true>(c.lds, g, S, E, t3); }
        }
    } PHASE_END(PH_WOUT + 1)
    PHASE_BEGIN(PH_WOUT + 2) { P_(bf16_t, H, WS_A); P_(bf16_t, Wd_t, WS_WD); P_(bf16_t, YB3, WS_B);
        GEMM_RES(H, Wd_t, FF, (const float*)nullptr, a.out, YB3, RSTAT(2), (const float*)RSTAT(1), a.in[I_LN2G], a.in[I_LN2B], 0.5f); } PHASE_END(PH_WOUT + 2)
    PHASE_BEGIN(PH_WOUT + 3) {
        P_(bf16_t, YB3, WS_B); P_(bf16_t, Wpg_t, WS_WPG); P_(bf16_t, PROJ, WS_XB);
        { pg8::Gemm g{YB3, Wpg_t, M, D, D}; pg8::StaticOrder S; S.init(M, D, c.G, c.bx);
          EpiGate E{a.out, PROJ, a.in[I_PBIAS], RSTAT(2), (const float*)(ws + WS_C1PG), (const float*)(ws + WS_C2PG), a.in[I_LN3G], a.in[I_LN3B]};
          pg8::gemm_phase<EpiGate, pg8::StaticOrder, PG_ALIGN, true>(c.lds, g, S, E, c.tid); }
    } PHASE_END(PH_WOUT + 3)
}

#ifndef MK_SPLIT
#define MK_SPLIT 0
#endif
extern "C" void kernel_launch(void* const* d_in, const int* in_sizes, int n_in, void* d_out, int out_size, void* d_ws, size_t ws_size, hipStream_t stream) {
    static int ready = 0;
    if (!ready) {
        if (n_in != 30 || out_size != M * D || ws_size < WS_END) { fprintf(stderr, "kernel_launch: unexpected problem (n_in %d out %d ws %zu)\n", n_in, out_size, ws_size); ready = -1; return; }
        if (hipFuncSetAttribute((const void*)mk_fwd, hipFuncAttributeMaxDynamicSharedMemorySize, LDS_BYTES) != hipSuccess) { fprintf(stderr, "kernel_launch: hipFuncSetAttribute failed\n"); ready = -1; return; }
        int per_cu = 0; (void)hipOccupancyMaxActiveBlocksPerMultiprocessor(&per_cu, (const void*)mk_fwd, 512, LDS_BYTES); (void)hipGetLastError();
        ready = 1;
    }
    if (ready < 0) return;
    if (hipMemsetAsync(d_ws, 0, 16384, stream) != hipSuccess) { fprintf(stderr, "kernel_launch: memset failed\n"); return; }
    Args a{};
    for (int i = 0; i < 30; ++i) a.in[i] = (const float*)d_in[i];
    a.out = (float*)d_out; a.ws = (unsigned char*)d_ws;
#if MK_SPLIT
    for (int ph = 0; ph < NPH; ++ph) { a.ph_lo = ph; a.ph_hi = ph + 1; hipLaunchKernelGGL(mk_fwd, dim3(256), dim3(512), LDS_BYTES, stream, a); }
#else
    a.ph_lo = 0; a.ph_hi = NPH;
    void* args[] = {&a};
    hipError_t e = hipLaunchCooperativeKernel((const void*)mk_fwd, dim3(256), dim3(512), args, LDS_BYTES, stream);
    if (e != hipSuccess) fprintf(stderr, "kernel_launch: cooperative launch failed: %s\n", hipGetErrorString(e));
#endif
}
```

```cpp
#include <hip/hip_runtime.h>
#include <hip/hip_cooperative_groups.h>
#include <cstdio>
#include <cstdint>
namespace cg = cooperative_groups;
namespace pg8 {
#define PG8_LAS __attribute__((address_space(3)))
typedef unsigned short bf16_t;
typedef short bf16x8 __attribute__((ext_vector_type(8)));
typedef float f32x4 __attribute__((ext_vector_type(4)));
typedef unsigned u32x4 __attribute__((ext_vector_type(4)));
constexpr int BM = 256, BK = 64, HALF = 128, HTB = HALF * BK * 2  , STAGE_BYTES = 8 * HTB, NXCD = 8, WGM = 4;

__host__ __device__ __forceinline__ int lds_byte(int r, int c) { const int st = (r >> 4) * 2 + (c >> 5), rr = r & 15, cc = c & 31, ob = rr * 64 + cc * 2; return st * 1024 + (ob ^ (((ob >> 9) & 1) << 5)); }
__host__ __device__ __forceinline__ void stage_rc(int b, int& R, int& C) { const int st = b / 1024, sb = b % 1024, swz = sb ^ (((sb >> 9) & 1) << 5); R = (st >> 1) * 16 + swz / 64; C = (st & 1) * 32 + (swz % 64) / 2; }
__host__ __device__ __forceinline__ int perm32(int rho) { const int n = rho >> 4, i = rho & 15; return 8 * (i >> 2) + 4 * n + (i & 3); }

struct Unit { int pm, pn; };
struct Gemm { const bf16_t* A; const bf16_t* Bt; int M, N, K; };

struct StaticOrder {
    int nM, nN, nwg, G, c;
    __host__ __device__ void init(int M, int N, int G_, int c_) { nM = M / BM; nN = N / BM; nwg = nM * nN; G = G_; c = c_; }
    __host__ __device__ bool next(int i, Unit& u) const {
        const long L = (long)i * G + c; if (L >= nwg) return false;
        int wgid = (int)L; { const int q = nwg / NXCD, r = nwg % NXCD, xcd = wgid % NXCD, off = wgid / NXCD; wgid = (xcd < r ? xcd * (q + 1) : r * (q + 1) + (xcd - r) * q) + off; }
        const int nig = WGM * nN, gid = wgid / nig, fm = gid * WGM, gsz = (nM - fm) < WGM ? (nM - fm) : WGM;
        u.pm = fm + ((wgid % nig) % gsz); u.pn = (wgid % nig) / gsz; return true;
    }
    __device__ __forceinline__ void a_ready(const Unit&) const {}
    __device__ __forceinline__ void done(const Unit&) const {}
};

__device__ __forceinline__ unsigned cvt_pk_bf16(float lo, float hi) { unsigned r; asm volatile("v_cvt_pk_bf16_f32 %0, %1, %2" : "=v"(r) : "v"(lo), "v"(hi)); return r; }
typedef float f32x2 __attribute__((ext_vector_type(2)));
template <class Epi, class Sched, bool ALIGN_EPI = false, bool SP2 = false>
__device__ __forceinline__ void gemm_phase(PG8_LAS unsigned char* lds, const Gemm g, const Sched& S, const Epi& E, const int tid) {
    const int wid = __builtin_amdgcn_readfirstlane(tid >> 6), lane = tid & 63, wr = wid >> 2, wc = wid & 3, fr = lane & 15, fq = lane >> 4;
    const int K = g.K, nt = K / BK;
    unsigned voffA[2], voffB[2];
#pragma unroll
    for (int i = 0; i < 2; ++i) { int R, C; stage_rc(tid * 16 + i * 8192, R, C); const int Rb = Epi::PERM ? ((R & ~31) + perm32(R & 31)) : R;
        voffA[i] = (unsigned)(R * K + C) * 2u; voffB[i] = (unsigned)(Rb * K + C) * 2u; }
    const size_t kstep = (size_t)(BK * 2);
    const size_t hstep = (size_t)HALF * K * 2;
    const size_t tstep = 2 * hstep;
    const unsigned ldsw = (unsigned)wid * 1024u;
    const int aoff = lds_byte(wr * 64 + fr, fq * 8), boff = lds_byte(wc * 32 + fr, fq * 8);
#define PG8_SA(b, h) (((b) * 2 + (h)) * HTB)
#define PG8_SB(b, h) ((4 + (b) * 2 + (h)) * HTB)
#define PG8_STAGE(bufoff, gbase, voff) do { _Pragma("unroll") for (int _i = 0; _i < 2; ++_i) \
        __builtin_amdgcn_global_load_lds((const unsigned*)((const char*)(gbase) + (voff)[_i]), (PG8_LAS unsigned*)(lds + (bufoff) + ldsw + _i * 8192), 16, 0, 0); } while (0)
#define PG8_LDA(dst, b, h) do { _Pragma("unroll") for (int m = 0; m < 4; ++m) _Pragma("unroll") for (int k = 0; k < 2; ++k) dst[m][k] = *(const PG8_LAS bf16x8*)(lds + PG8_SA(b, h) + aoff + m * 2048 + k * 1024); } while (0)
#define PG8_LDB(dst, b, h) do { _Pragma("unroll") for (int n = 0; n < 2; ++n) _Pragma("unroll") for (int k = 0; k < 2; ++k) dst[n][k] = *(const PG8_LAS bf16x8*)(lds + PG8_SB(b, h) + boff + n * 2048 + k * 1024); } while (0)
#define PG8_MMA(ai, bj, At, Bt) do { __builtin_amdgcn_s_setprio(1); _Pragma("unroll") for (int m = 0; m < 4; ++m) _Pragma("unroll") for (int n = 0; n < 2; ++n) _Pragma("unroll") for (int k = 0; k < 2; ++k) \
        acc[ai][bj][m][n] = __builtin_amdgcn_mfma_f32_16x16x32_bf16(Bt[n][k], At[m][k], acc[ai][bj][m][n], 0, 0, 0); __builtin_amdgcn_s_setprio(0); } while (0)
#define PG8_WAIT_V(n) asm volatile("s_waitcnt vmcnt(" #n ")" ::: "memory")
#define PG8_WAIT_L(n) asm volatile("s_waitcnt lgkmcnt(" #n ")" ::: "memory")
#define PG8_BAR __builtin_amdgcn_s_barrier()
#define PG8_SCHED __builtin_amdgcn_sched_barrier(0)
    Unit cur, nxt; int ui = 0;
    if (!S.next(0, cur)) return;
    f32x4 acc[2][2][4][2];
#pragma unroll
    for (int a = 0; a < 2; ++a)
#pragma unroll
        for (int b = 0; b < 2; ++b)
#pragma unroll
            for (int m = 0; m < 4; ++m)
#pragma unroll
                for (int n = 0; n < 2; ++n) acc[a][b][m][n] = (f32x4){0.f, 0.f, 0.f, 0.f};
    bf16x8 At[4][2], B0[2][2], B1[2][2];
    const char* cA = (const char*)g.A + (size_t)cur.pm * tstep; const char* cB = (const char*)g.Bt + (size_t)cur.pn * tstep;
    S.a_ready(cur);
    if constexpr (SP2) {
        PG8_STAGE(PG8_SB(0, 0), cB, voffB); PG8_STAGE(PG8_SB(0, 1), cB + hstep, voffB); PG8_STAGE(PG8_SA(0, 0), cA, voffA); PG8_STAGE(PG8_SA(0, 1), cA + hstep, voffA);
        if (wr == 1) PG8_BAR;
        PG8_WAIT_V(2); PG8_BAR;
        PG8_STAGE(PG8_SB(1, 0), cB + kstep, voffB); PG8_STAGE(PG8_SA(1, 0), cA + kstep, voffA); PG8_STAGE(PG8_SB(1, 1), cB + hstep + kstep, voffB);
        PG8_WAIT_V(6); PG8_BAR;
    } else {
        PG8_STAGE(PG8_SB(0, 0), cB, voffB); PG8_STAGE(PG8_SA(0, 0), cA, voffA); PG8_STAGE(PG8_SB(0, 1), cB + hstep, voffB); PG8_STAGE(PG8_SA(0, 1), cA + hstep, voffA);
        if (wr == 1) PG8_BAR;
        PG8_WAIT_V(4); PG8_BAR;
        PG8_STAGE(PG8_SB(1, 0), cB + kstep, voffB); PG8_STAGE(PG8_SA(1, 0), cA + kstep, voffA); PG8_STAGE(PG8_SB(1, 1), cB + hstep + kstep, voffB);
        PG8_WAIT_V(6); PG8_BAR;
    }
    for (;;) {
        const bool has_next = S.next(ui + 1, nxt);
        const char* nA = has_next ? (const char*)g.A + (size_t)nxt.pm * tstep : cA; const char* nB = has_next ? (const char*)g.Bt + (size_t)nxt.pn * tstep : cB;
        for (int t = 0; t < nt; t += 2) {
            const bool last = (t == nt - 2);
            const char* a1 = cA + (size_t)(t + 1) * kstep;
            const char* a2 = last ? nA : cA + (size_t)(t + 2) * kstep; const char* b2 = last ? nB : cB + (size_t)(t + 2) * kstep;
            const char* a3 = a2 + kstep; const char* b3 = b2 + kstep;
            if (last && has_next) S.a_ready(nxt);
            if constexpr (SP2) {
            PG8_LDB(B0, 0, 0); PG8_LDB(B1, 0, 1); PG8_SCHED; PG8_LDA(At, 0, 0); PG8_STAGE(PG8_SA(1, 1), a1 + hstep, voffA);
            PG8_WAIT_V(8); PG8_WAIT_L(0); PG8_BAR; PG8_MMA(0, 0, At, B0); PG8_MMA(0, 1, At, B1); PG8_BAR; PG8_SCHED;
            PG8_LDA(At, 0, 1); PG8_STAGE(PG8_SB(0, 0), b2, voffB); PG8_STAGE(PG8_SB(0, 1), b2 + hstep, voffB); PG8_STAGE(PG8_SA(0, 0), a2, voffA);
            PG8_WAIT_V(8); PG8_WAIT_L(0); PG8_BAR; PG8_MMA(1, 0, At, B0); PG8_MMA(1, 1, At, B1); PG8_BAR; PG8_SCHED;
            PG8_LDB(B0, 1, 0); PG8_LDB(B1, 1, 1); PG8_SCHED; PG8_LDA(At, 1, 0); PG8_STAGE(PG8_SA(0, 1), a2 + hstep, voffA);
            PG8_WAIT_V(8); PG8_WAIT_L(0); PG8_BAR; PG8_MMA(0, 0, At, B0); PG8_MMA(0, 1, At, B1); PG8_BAR; PG8_SCHED;
            PG8_LDA(At, 1, 1); PG8_STAGE(PG8_SB(1, 0), b3, voffB); PG8_STAGE(PG8_SB(1, 1), b3 + hstep, voffB); PG8_STAGE(PG8_SA(1, 0), a3, voffA);
            PG8_WAIT_V(8); PG8_WAIT_L(0); PG8_BAR; PG8_MMA(1, 0, At, B0); PG8_MMA(1, 1, At, B1); PG8_BAR; PG8_SCHED;
            } else {
            PG8_LDB(B0, 0, 0); PG8_SCHED; PG8_LDA(At, 0, 0); PG8_STAGE(PG8_SA(1, 1), a1 + hstep, voffA);
            PG8_WAIT_L(8); PG8_BAR; PG8_WAIT_L(0); PG8_MMA(0, 0, At, B0); PG8_BAR; PG8_SCHED;
            PG8_LDB(B1, 0, 1); PG8_STAGE(PG8_SB(0, 0), b2, voffB);
            PG8_BAR; PG8_WAIT_L(0); PG8_MMA(0, 1, At, B1); PG8_BAR;
            PG8_LDA(At, 0, 1); PG8_STAGE(PG8_SA(0, 0), a2, voffA);
            PG8_BAR; PG8_WAIT_L(0); PG8_MMA(1, 0, At, B0); PG8_BAR; PG8_SCHED;
            PG8_STAGE(PG8_SB(0, 1), b2 + hstep, voffB);
            PG8_WAIT_V(6); PG8_BAR; PG8_MMA(1, 1, At, B1); PG8_BAR;
            PG8_LDB(B0, 1, 0); PG8_SCHED; PG8_LDA(At, 1, 0); PG8_STAGE(PG8_SA(0, 1), a2 + hstep, voffA);
            PG8_WAIT_L(8); PG8_BAR; PG8_WAIT_L(0); PG8_MMA(0, 0, At, B0); PG8_BAR; PG8_SCHED;
            PG8_LDB(B1, 1, 1); PG8_STAGE(PG8_SB(1, 0), b3, voffB);
            PG8_BAR; PG8_WAIT_L(0); PG8_MMA(0, 1, At, B1); PG8_BAR;
            PG8_LDA(At, 1, 1); PG8_STAGE(PG8_SA(1, 0), a3, voffA);
            PG8_BAR; PG8_WAIT_L(0); PG8_MMA(1, 0, At, B0); PG8_BAR; PG8_SCHED;
            PG8_STAGE(PG8_SB(1, 1), b3 + hstep, voffB);
            PG8_WAIT_V(6); PG8_BAR; PG8_MMA(1, 1, At, B1); PG8_BAR;
            }
        }
        if constexpr (ALIGN_EPI) { if (wr == 0) PG8_BAR; }
        if constexpr (!Epi::AFTER_DRAIN) { E(acc, cur, wr, wc, fr, fq); S.done(cur); }
        if (!has_next) break;
#pragma unroll
        for (int a = 0; a < 2; ++a)
#pragma unroll
            for (int b = 0; b < 2; ++b)
#pragma unroll
                for (int m = 0; m < 4; ++m)
#pragma unroll
                    for (int n = 0; n < 2; ++n) acc[a][b][m][n] = (f32x4){0.f, 0.f, 0.f, 0.f};
        cur = nxt; cA = nA; cB = nB; ++ui;
        if constexpr (ALIGN_EPI) { if (wr == 1) PG8_BAR; }
    }
    PG8_WAIT_V(0);
    if constexpr (!ALIGN_EPI) { if (wr == 0) PG8_BAR; }
    PG8_BAR;
    if constexpr (Epi::AFTER_DRAIN) { E.fused(acc, cur, wr, wc, fr, fq, lds, wid, lane); S.done(cur); }
#undef PG8_SA
#undef PG8_SB
#undef PG8_STAGE
#undef PG8_LDA
#undef PG8_LDB
#undef PG8_MMA
#undef PG8_WAIT_V
#undef PG8_WAIT_L
#undef PG8_BAR
#undef PG8_SCHED
}
}

#define DI __device__ __forceinline__
#define LAS __attribute__((address_space(3)))
using pg8::bf16_t; using pg8::f32x4; using pg8::u32x4; using pg8::Unit; using pg8::cvt_pk_bf16;
typedef unsigned u32x2 __attribute__((ext_vector_type(2)));
typedef float f32x2v __attribute__((ext_vector_type(2)));

constexpr int M = 16384, D = 1024, SEQ = 4096, FF = 2816, NGU = 5632, NIN = 3872, NINP = 4096, KL = 384, NL = 1536, DP = 256;
constexpr int TR = 512, NR = SEQ / TR, REC = 384;
constexpr float ALPHA = 1.189207115002721f;
constexpr size_t MiB = (size_t)1 << 20;
constexpr size_t WS_ST = MiB / 2, WS_CS = 1 * MiB, WS_WGU = 2 * MiB, WS_WD = 13 * MiB, WS_WIN = 19 * MiB, WS_WLORA = 27 * MiB, WS_WOUT = 29 * MiB,
                 WS_WPG = 31 * MiB, WS_WPP = 33 * MiB, WS_PB = 34 * MiB, WS_XB = 42 * MiB, WS_A = 74 * MiB, WS_B = 162 * MiB, WS_SC = 226 * MiB, WS_END = 254 * MiB;
constexpr int LDS_BYTES = 136 * 1024;
constexpr size_t WS_C1WIN = 16384, WS_C2WIN = WS_C1WIN + 16384, WS_C1GU = WS_C2WIN + 16384, WS_C2GU = WS_C1GU + 24576, WS_C1PG = WS_C2GU + 24576, WS_C2PG = WS_C1PG + 4096, WS_RSTAT = 131072, WS_ZERO_BYTES = 524288;
constexpr float LN_EPS = 1e-5f;
#ifndef PG_ALIGN
#define PG_ALIGN true
#endif
#ifndef DUP_GEMM
#define DUP_GEMM 1
#endif
#ifndef DUP_RET
#define DUP_RET 1
#endif
#ifndef DUP_MISC
#define DUP_MISC 1
#endif

constexpr int NPH = 12 + (NR + 2);

DI int launder_v(int x) { asm volatile("" : "+v"(x)); return x; }
DI float bf2f(bf16_t v) { return __uint_as_float((unsigned)v << 16); }
DI bf16_t f2bf(float x) { return (bf16_t)(cvt_pk_bf16(x, 0.f) & 0xffffu); }
template <int CTRL> DI float dpp_f(float x) { return __builtin_bit_cast(float, __builtin_amdgcn_update_dpp(0, __builtin_bit_cast(int, x), CTRL, 0xf, 0xf, true)); }
DI float red16(float x) { x += dpp_f<0xB1>(x); x += dpp_f<0x4E>(x); x += dpp_f<0x141>(x); x += dpp_f<0x140>(x); return x; }
DI float sum_rows4(float x) {
    float a = x, b = x; asm("s_nop 1\n\tv_permlane16_swap_b32 %0, %1\n\ts_nop 1" : "+v"(a), "+v"(b)); x = a + b;
    a = x; b = x; asm("s_nop 1\n\tv_permlane32_swap_b32 %0, %1\n\ts_nop 1" : "+v"(a), "+v"(b)); return a + b;
}
DI float wave_sum(float v) { return sum_rows4(red16(v)); }
DI float sigmoidf_(float x) { return 1.0f / (1.0f + __expf(-x)); }
DI float silu_fast(float x) { return x * __builtin_amdgcn_rcpf(1.0f + __expf(-x)); }

DI void row_stats(const float* stat, int row, float& mu, float& rstd) {
    const f32x2v st = *(const f32x2v*)(stat + 2 * (size_t)row); mu = st.x * (1.0f / D); const float var = fmaxf(st.y * (1.0f / D) - mu * mu, 0.f); rstd = 1.0f / sqrtf(var + LN_EPS);
}
DI f32x4 ln_fix(f32x4 a, float mu, float rstd, f32x4 c1, f32x4 c2) { return (a - c1 * mu) * rstd + c2; }
struct EpiGU {
    static constexpr bool PERM = true, AFTER_DRAIN = false; bf16_t* H; const float* stat; const float* c1; const float* c2;
    DI void operator()(const f32x4 (&acc)[2][2][4][2], const Unit& u, int wr, int wc, int fr, int fq) const {
        const int row0 = u.pm * 256 + wr * 64 + fr, col0 = u.pn * 128 + wc * 32 + 8 * fq;
        f32x4 cc1[4], cc2[4];
        if (stat) { const int pc = u.pn * 256 + wc * 32 + 8 * fq;
            cc1[0] = *(const f32x4*)(c1 + pc); cc1[1] = *(const f32x4*)(c1 + pc + 4); cc1[2] = *(const f32x4*)(c1 + pc + 128); cc1[3] = *(const f32x4*)(c1 + pc + 132);
            cc2[0] = *(const f32x4*)(c2 + pc); cc2[1] = *(const f32x4*)(c2 + pc + 4); cc2[2] = *(const f32x4*)(c2 + pc + 128); cc2[3] = *(const f32x4*)(c2 + pc + 132); }
#pragma unroll
        for (int ai = 0; ai < 2; ++ai)
#pragma unroll
            for (int m = 0; m < 4; ++m) {
                bf16_t* p = H + (size_t)(row0 + ai * 128 + m * 16) * FF + col0;
                f32x4 g0 = acc[ai][0][m][0], g1 = acc[ai][0][m][1], u0 = acc[ai][1][m][0], u1 = acc[ai][1][m][1];
                if (stat) { float mu, rstd; row_stats(stat, row0 + ai * 128 + m * 16, mu, rstd);
                    g0 = ln_fix(g0, mu, rstd, cc1[0], cc2[0]); g1 = ln_fix(g1, mu, rstd, cc1[1], cc2[1]); u0 = ln_fix(u0, mu, rstd, cc1[2], cc2[2]); u1 = ln_fix(u1, mu, rstd, cc1[3], cc2[3]); }
                u32x4 w;
                w.x = cvt_pk_bf16(silu_fast(g0[0]) * u0[0], silu_fast(g0[1]) * u0[1]); w.y = cvt_pk_bf16(silu_fast(g0[2]) * u0[2], silu_fast(g0[3]) * u0[3]);
                w.z = cvt_pk_bf16(silu_fast(g1[0]) * u1[0], silu_fast(g1[1]) * u1[1]); w.w = cvt_pk_bf16(silu_fast(g1[2]) * u1[2], silu_fast(g1[3]) * u1[3]);
                *(u32x4*)p = w;
            }
    }
};
struct EpiRes {
    static constexpr bool PERM = true, AFTER_DRAIN = false; const float* Xraw; float* Yio; bf16_t* YB; float* stat_out; const float* ln_stat; const float* ln_g; const float* ln_b; float s;
    DI void operator()(const f32x4 (&acc)[2][2][4][2], const Unit& u, int wr, int wc, int fr, int fq) const {
        const int row0 = u.pm * 256 + wr * 64 + fr, col0 = u.pn * 256 + wc * 32 + 8 * fq;
        f32x4 gv[2][2], bv[2][2];
        if (ln_stat) {
#pragma unroll
            for (int bj = 0; bj < 2; ++bj) { gv[bj][0] = *(const f32x4*)(ln_g + col0 + bj * 128); gv[bj][1] = *(const f32x4*)(ln_g + col0 + bj * 128 + 4); bv[bj][0] = *(const f32x4*)(ln_b + col0 + bj * 128); bv[bj][1] = *(const f32x4*)(ln_b + col0 + bj * 128 + 4); }
        }
#pragma unroll
        for (int ai = 0; ai < 2; ++ai)
#pragma unroll
            for (int m = 0; m < 4; ++m) {
                const int row = row0 + ai * 128 + m * 16; float mu = 0.f, rstd = 1.f; if (ln_stat) row_stats(ln_stat, row, mu, rstd);
                float rs = 0.f, rq = 0.f;
#pragma unroll
                for (int bj = 0; bj < 2; ++bj) {
                    const size_t off = (size_t)row * D + col0 + bj * 128;
                    f32x4 x0, x1;
                    if (ln_stat) { x0 = *(const f32x4*)(Yio + off); x1 = *(const f32x4*)(Yio + off + 4);
                        x0 = (x0 - mu) * rstd * gv[bj][0] + bv[bj][0]; x1 = (x1 - mu) * rstd * gv[bj][1] + bv[bj][1]; }
                    else { x0 = *(const f32x4*)(Xraw + off); x1 = *(const f32x4*)(Xraw + off + 4); }
                    const f32x4 y0 = x0 * ALPHA + acc[ai][bj][m][0] * s, y1 = x1 * ALPHA + acc[ai][bj][m][1] * s;
                    *(f32x4*)(Yio + off) = y0; *(f32x4*)(Yio + off + 4) = y1;
                    u32x4 w; w.x = cvt_pk_bf16(y0[0], y0[1]); w.y = cvt_pk_bf16(y0[2], y0[3]); w.z = cvt_pk_bf16(y1[0], y1[1]); w.w = cvt_pk_bf16(y1[2], y1[3]);
                    *(u32x4*)(YB + off) = w;
                    rs += (y0[0] + y0[1]) + (y0[2] + y0[3]) + (y1[0] + y1[1]) + (y1[2] + y1[3]);
                    rq += (y0[0] * y0[0] + y0[1] * y0[1]) + (y0[2] * y0[2] + y0[3] * y0[3]) + (y1[0] * y1[0] + y1[1] * y1[1]) + (y1[2] * y1[2] + y1[3] * y1[3]);
                }
                rs = sum_rows4(rs); rq = sum_rows4(rq);
                if (fq == 0) { atomicAdd(stat_out + 2 * (size_t)row, rs); atomicAdd(stat_out + 2 * (size_t)row + 1, rq); }
            }
    }
};
struct EpiWin {
    static constexpr bool PERM = true, AFTER_DRAIN = false; bf16_t* ZRET; bf16_t* ZRW; const float* CS; const float* stat; const float* c1; const float* c2;
    DI void operator()(const f32x4 (&acc)[2][2][4][2], const Unit& u, int wr, int wc, int fr, int fq) const {
        const int row0 = u.pm * 256 + wr * 64 + fr;
        f32x4 cc1[4], cc2[4];
        { const int pc = u.pn * 256 + wc * 32 + 8 * fq;
            cc1[0] = *(const f32x4*)(c1 + pc); cc1[1] = *(const f32x4*)(c1 + pc + 4); cc1[2] = *(const f32x4*)(c1 + pc + 128); cc1[3] = *(const f32x4*)(c1 + pc + 132);
            cc2[0] = *(const f32x4*)(c2 + pc); cc2[1] = *(const f32x4*)(c2 + pc + 4); cc2[2] = *(const f32x4*)(c2 + pc + 128); cc2[3] = *(const f32x4*)(c2 + pc + 132); }
        if (u.pn < 4) {
            const int sec = u.pn >> 1, head = (u.pn & 1) * 4 + wc; const float sc = sec ? 0.125f : 1.0f;
#pragma unroll
            for (int ai = 0; ai < 2; ++ai)
#pragma unroll
                for (int m = 0; m < 4; ++m) {
                    const int row = row0 + ai * 128 + m * 16, pos = row & (SEQ - 1);
                    const f32x4* cs = (const f32x4*)(CS + ((size_t)pos * 32 + 8 * fq) * 2);
                    const f32x4 c01 = cs[0], c23 = cs[1], c45 = cs[2], c67 = cs[3];
                    float mu, rstd; row_stats(stat, row, mu, rstd);
                    const f32x4 a0 = ln_fix(acc[ai][0][m][0], mu, rstd, cc1[0], cc2[0]), a1 = ln_fix(acc[ai][0][m][1], mu, rstd, cc1[1], cc2[1]),
                                b0 = ln_fix(acc[ai][1][m][0], mu, rstd, cc1[2], cc2[2]), b1 = ln_fix(acc[ai][1][m][1], mu, rstd, cc1[3], cc2[3]);
                    u32x4 o1, o2;
                    o1.x = cvt_pk_bf16((a0[0] * c01[0] - b0[0] * c01[1]) * sc, (a0[1] * c01[2] - b0[1] * c01[3]) * sc);
                    o1.y = cvt_pk_bf16((a0[2] * c23[0] - b0[2] * c23[1]) * sc, (a0[3] * c23[2] - b0[3] * c23[3]) * sc);
                    o1.z = cvt_pk_bf16((a1[0] * c45[0] - b1[0] * c45[1]) * sc, (a1[1] * c45[2] - b1[1] * c45[3]) * sc);
                    o1.w = cvt_pk_bf16((a1[2] * c67[0] - b1[2] * c67[1]) * sc, (a1[3] * c67[2] - b1[3] * c67[3]) * sc);
                    o2.x = cvt_pk_bf16((a0[0] * c01[1] + b0[0] * c01[0]) * sc, (a0[1] * c01[3] + b0[1] * c01[2]) * sc);
                    o2.y = cvt_pk_bf16((a0[2] * c23[1] + b0[2] * c23[0]) * sc, (a0[3] * c23[3] + b0[3] * c23[2]) * sc);
                    o2.z = cvt_pk_bf16((a1[0] * c45[1] + b1[0] * c45[0]) * sc, (a1[1] * c45[3] + b1[1] * c45[2]) * sc);
                    o2.w = cvt_pk_bf16((a1[2] * c67[1] + b1[2] * c67[0]) * sc, (a1[3] * c67[3] + b1[3] * c67[2]) * sc);
                    bf16_t* p = ZRET + (size_t)row * 2048 + sec * 512 + head * 64 + 8 * fq;
                    *(u32x4*)p = o1; *(u32x4*)(p + 32) = o2;
                }
        } else {
            bf16_t* base = (u.pn < 8) ? ZRET + u.pn * 256 : ZRW + (u.pn - 8) * 256;
            const int col0 = wc * 32 + 8 * fq;
#pragma unroll
            for (int ai = 0; ai < 2; ++ai)
#pragma unroll
                for (int m = 0; m < 4; ++m)
#pragma unroll
                    for (int bj = 0; bj < 2; ++bj) {
                        float mu, rstd; row_stats(stat, row0 + ai * 128 + m * 16, mu, rstd);
                        const f32x4 v0 = ln_fix(acc[ai][bj][m][0], mu, rstd, cc1[2 * bj], cc2[2 * bj]), v1 = ln_fix(acc[ai][bj][m][1], mu, rstd, cc1[2 * bj + 1], cc2[2 * bj + 1]); u32x4 w;
                        w.x = cvt_pk_bf16(v0[0], v0[1]); w.y = cvt_pk_bf16(v0[2], v0[3]); w.z = cvt_pk_bf16(v1[0], v1[1]); w.w = cvt_pk_bf16(v1[2], v1[3]);
                        *(u32x4*)(base + (size_t)(row0 + ai * 128 + m * 16) * 2048 + col0 + bj * 128) = w;
                    }
        }
    }
};
DI float decay_from_lora(float x) { const float nx = -x; const float sp = fmaxf(nx, 0.f) + log1pf(__expf(-fabsf(nx))); return __expf(-__expf(-sp - 0.5f)); }
struct EpiLora {
    static constexpr bool PERM = true, AFTER_DRAIN = false; float* LW; bf16_t* LA2; bf16_t* LG; const float* w0; const float* a0;
    DI void operator()(const f32x4 (&acc)[2][2][4][2], const Unit& u, int wr, int wc, int fr, int fq) const {
        const int row0 = u.pm * 256 + wr * 64 + fr, kind = u.pn >> 1, cb = (u.pn & 1) * 256 + wc * 32 + 8 * fq;
        if (kind == 0) {
#pragma unroll
            for (int bj = 0; bj < 2; ++bj) {
                const f32x4 bi0 = *(const f32x4*)(w0 + cb + bj * 128), bi1 = *(const f32x4*)(w0 + cb + bj * 128 + 4);
#pragma unroll
                for (int ai = 0; ai < 2; ++ai)
#pragma unroll
                    for (int m = 0; m < 4; ++m) {
                        const size_t off = (size_t)(row0 + ai * 128 + m * 16) * 512 + cb + bj * 128;
                        const f32x4 v0 = acc[ai][bj][m][0] + bi0, v1 = acc[ai][bj][m][1] + bi1; f32x4 o0, o1;
                        o0 = v0; o1 = v1;
                        *(f32x4*)(LW + off) = o0; *(f32x4*)(LW + off + 4) = o1;
                    }
            }
        } else if (kind == 1) {
#pragma unroll
            for (int bj = 0; bj < 2; ++bj) {
                const f32x4 bi0 = *(const f32x4*)(a0 + cb + bj * 128), bi1 = *(const f32x4*)(a0 + cb + bj * 128 + 4);
#pragma unroll
                for (int ai = 0; ai < 2; ++ai)
#pragma unroll
                    for (int m = 0; m < 4; ++m) {
                        const size_t off = (size_t)(row0 + ai * 128 + m * 16) * 512 + cb + bj * 128;
                        const f32x4 v0 = acc[ai][bj][m][0] + bi0, v1 = acc[ai][bj][m][1] + bi1; u32x4 w;
                        w.x = cvt_pk_bf16(v0[0], v0[1]); w.y = cvt_pk_bf16(v0[2], v0[3]); w.z = cvt_pk_bf16(v1[0], v1[1]); w.w = cvt_pk_bf16(v1[2], v1[3]);
                        *(u32x4*)(LA2 + off) = w;
                    }
            }
        } else {
#pragma unroll
            for (int bj = 0; bj < 2; ++bj)
#pragma unroll
                for (int ai = 0; ai < 2; ++ai)
#pragma unroll
                    for (int m = 0; m < 4; ++m) {
                        const size_t off = (size_t)(row0 + ai * 128 + m * 16) * 512 + cb + bj * 128;
                        const f32x4 v0 = acc[ai][bj][m][0], v1 = acc[ai][bj][m][1]; u32x4 w;
                        w.x = cvt_pk_bf16(v0[0], v0[1]); w.y = cvt_pk_bf16(v0[2], v0[3]); w.z = cvt_pk_bf16(v1[0], v1[1]); w.w = cvt_pk_bf16(v1[2], v1[3]);
                        *(u32x4*)(LG + off) = w;
                    }
        }
    }
};
struct EpiProj {
    static constexpr bool PERM = true, AFTER_DRAIN = false; bf16_t* P;
    DI void operator()(const f32x4 (&acc)[2][2][4][2], const Unit& u, int wr, int wc, int fr, int fq) const {
        const int row0 = u.pm * 256 + wr * 64 + fr, col0 = u.pn * 256 + wc * 32 + 8 * fq;
#pragma unroll
        for (int ai = 0; ai < 2; ++ai)
#pragma unroll
            for (int m = 0; m < 4; ++m)
#pragma unroll
                for (int bj = 0; bj < 2; ++bj) {
                    const size_t off = (size_t)(row0 + ai * 128 + m * 16) * D + col0 + bj * 128;
                    const f32x4 v0 = acc[ai][bj][m][0], v1 = acc[ai][bj][m][1]; u32x4 w;
                    w.x = cvt_pk_bf16(v0[0], v0[1]); w.y = cvt_pk_bf16(v0[2], v0[3]); w.z = cvt_pk_bf16(v1[0], v1[1]); w.w = cvt_pk_bf16(v1[2], v1[3]);
                    *(u32x4*)(P + off) = w;
                }
    }
};
struct EpiGate {
    static constexpr bool PERM = true, AFTER_DRAIN = false; float* XO; const bf16_t* P; const float* bias; const float* stat; const float* c1; const float* c2; const float* ln_g; const float* ln_b;
    DI void operator()(const f32x4 (&acc)[2][2][4][2], const Unit& u, int wr, int wc, int fr, int fq) const {
        const int row0 = u.pm * 256 + wr * 64 + fr, col0 = u.pn * 256 + wc * 32 + 8 * fq;
#pragma unroll
        for (int ai = 0; ai < 2; ++ai)
#pragma unroll
            for (int m = 0; m < 4; ++m) {
                const int row = row0 + ai * 128 + m * 16; float mu, rstd; row_stats(stat, row, mu, rstd);
#pragma unroll
                for (int bj = 0; bj < 2; ++bj) {
                    const int col = col0 + bj * 128; const size_t off = (size_t)row * D + col;
                    const f32x4 bb0 = *(const f32x4*)(bias + col), bb1 = *(const f32x4*)(bias + col + 4);
                    const f32x4 g0 = ln_fix(acc[ai][bj][m][0], mu, rstd, *(const f32x4*)(c1 + col), *(const f32x4*)(c2 + col)) + bb0, g1 = ln_fix(acc[ai][bj][m][1], mu, rstd, *(const f32x4*)(c1 + col + 4), *(const f32x4*)(c2 + col + 4)) + bb1;
                    f32x4 x0 = *(const f32x4*)(XO + off), x1 = *(const f32x4*)(XO + off + 4); const u32x4 pw = *(const u32x4*)(P + off);
                    const f32x4 p0 = (f32x4){__uint_as_float(pw.x << 16), __uint_as_float(pw.x & 0xffff0000u), __uint_as_float(pw.y << 16), __uint_as_float(pw.y & 0xffff0000u)},
                                p1 = (f32x4){__uint_as_float(pw.z << 16), __uint_as_float(pw.z & 0xffff0000u), __uint_as_float(pw.w << 16), __uint_as_float(pw.w & 0xffff0000u)};
                    x0 = (x0 - mu) * rstd * *(const f32x4*)(ln_g + col) + *(const f32x4*)(ln_b + col); x1 = (x1 - mu) * rstd * *(const f32x4*)(ln_g + col + 4) + *(const f32x4*)(ln_b + col + 4);
                    f32x4 o0, o1;
#pragma unroll
                    for (int e = 0; e < 4; ++e) { o0[e] = x0[e] + sigmoidf_(g0[e]) * p0[e]; o1[e] = x1[e] + sigmoidf_(g1[e]) * p1[e]; }
                    *(f32x4*)(XO + off) = o0; *(f32x4*)(XO + off + 4) = o1;
                }
            }
    }
};

struct Ctx { int tid, lane, wave, bx, G, gw, NGW, gtid, NGT; LAS unsigned char* lds; };

DI void transpose_item(const float* __restrict__ W, int N, bf16_t* __restrict__ WT, int K, int dst_row0, int k0, int n0, LAS float* scr, int lane,
                       const float* lng = nullptr, const float* lnb = nullptr, float* c1 = nullptr, float* c2 = nullptr) {
    const int kr = lane >> 3, nq = (lane & 7) * 4;
    f32x4 v[8];
#pragma unroll
    for (int i = 0; i < 8; ++i) v[i] = *(const f32x4*)(W + (size_t)(k0 + kr + 8 * i) * N + n0 + nq);
    if (lng) {
        f32x4 cp = (f32x4){0.f, 0.f, 0.f, 0.f};
#pragma unroll
        for (int i = 0; i < 8; ++i) { cp = cp + v[i] * lnb[k0 + kr + 8 * i]; v[i] = v[i] * lng[k0 + kr + 8 * i]; }
#pragma unroll
        for (int j = 0; j < 4; ++j) { float t = cp[j]; t += __shfl_xor(t, 8); t += __shfl_xor(t, 16); t += __shfl_xor(t, 32); cp[j] = t; }
        if (lane < 8) {
#pragma unroll
            for (int j = 0; j < 4; ++j) atomicAdd(c2 + dst_row0 + nq + j, cp[j]);
        }
    }
#pragma unroll
    for (int i = 0; i < 8; ++i) { LAS float* d = scr + (kr + 8 * i) * 33 + nq; d[0] = v[i][0]; d[1] = v[i][1]; d[2] = v[i][2]; d[3] = v[i][3]; }
    asm volatile("s_waitcnt lgkmcnt(0)" ::: "memory");
    const int c = lane & 7;
#pragma unroll
    for (int j = 0; j < 4; ++j) { const int n = (lane >> 3) + 8 * j; const LAS float* s = scr + (8 * c) * 33 + n;
        u32x4 o; o.x = cvt_pk_bf16(s[0], s[33]); o.y = cvt_pk_bf16(s[66], s[99]); o.z = cvt_pk_bf16(s[132], s[165]); o.w = cvt_pk_bf16(s[198], s[231]);
        *(u32x4*)(WT + (size_t)(dst_row0 + n) * K + k0 + 8 * c) = o;
        if (lng) {
            float t = 0.f;
#pragma unroll
            for (int e = 0; e < 4; ++e) t += __uint_as_float(o[e] << 16) + __uint_as_float(o[e] & 0xffff0000u);
            t += __shfl_xor(t, 1); t += __shfl_xor(t, 2); t += __shfl_xor(t, 4);
            if (c == 0) atomicAdd(c1 + dst_row0 + n, t);
        } }
    asm volatile("s_waitcnt lgkmcnt(0)" ::: "memory");
}
DI int gu_dst_row(int c0) { const int isup = c0 >= FF; const int c = isup ? c0 - FF : c0; return 256 * (c >> 7) + 128 * isup + (c & 127); }
DI int win_dst_row(int c0) {
    if (c0 < 1024) { const int sec = c0 >> 9, hh = (c0 & 511) >> 6, half = (c0 & 63) >> 5; return 256 * (sec * 2 + (hh >> 2)) + 128 * half + 32 * (hh & 3); }
    return c0;
}
DI void cvt_rows_bf16(const Ctx& c, const float* src, bf16_t* dst, size_t n4) {
    for (size_t i = c.gtid; i < n4; i += c.NGT) { const f32x4 v = ((const f32x4*)src)[i]; u32x2 o; o.x = cvt_pk_bf16(v[0], v[1]); o.y = cvt_pk_bf16(v[2], v[3]); ((u32x2*)dst)[i] = o; }
}
DI void convert_ffn(const Ctx& c, const float* wgu, const float* wd, bf16_t* Wgu_t, bf16_t* Wd_t, const float* lng = nullptr, const float* lnb = nullptr, float* c1 = nullptr, float* c2 = nullptr) {
    LAS float* scr = (LAS float*)(c.lds + c.wave * 8448);
    for (int it = c.gw; it < 2816 + 1408; it += c.NGW) {
        if (it < 2816) { const int kb = it / 176, nb = it % 176; transpose_item(wgu, NGU, Wgu_t, D, gu_dst_row(32 * nb), 64 * kb, 32 * nb, scr, c.lane, lng, lnb, c1, c2); }
        else { const int r = it - 2816, kb = r / 32, nb = r % 32; transpose_item(wd, D, Wd_t, FF, 32 * nb, 64 * kb, 32 * nb, scr, c.lane); }
    }
}
DI void layer_norm_rows(const Ctx& c, const float* Y, const float* g, const float* b, float* XF, bf16_t* XB) {
    const f32x4 g0 = ((const f32x4*)g)[c.lane], g1 = ((const f32x4*)g)[c.lane + 64], g2 = ((const f32x4*)g)[c.lane + 128], g3 = ((const f32x4*)g)[c.lane + 192];
    const f32x4 b0 = ((const f32x4*)b)[c.lane], b1 = ((const f32x4*)b)[c.lane + 64], b2 = ((const f32x4*)b)[c.lane + 128], b3 = ((const f32x4*)b)[c.lane + 192];
    for (int m = c.gw; m < M; m += c.NGW) {
        const f32x4* yr = (const f32x4*)(Y + (size_t)m * D) + c.lane;
        f32x4 v0 = yr[0], v1 = yr[64], v2 = yr[128], v3 = yr[192];
        float s = (v0[0] + v0[1] + v0[2] + v0[3]) + (v1[0] + v1[1] + v1[2] + v1[3]) + (v2[0] + v2[1] + v2[2] + v2[3]) + (v3[0] + v3[1] + v3[2] + v3[3]);
        const float mean = wave_sum(s) * (1.0f / D);
        v0 = v0 - mean; v1 = v1 - mean; v2 = v2 - mean; v3 = v3 - mean;
        float q = (v0[0] * v0[0] + v0[1] * v0[1] + v0[2] * v0[2] + v0[3] * v0[3]) + (v1[0] * v1[0] + v1[1] * v1[1] + v1[2] * v1[2] + v1[3] * v1[3])
                + (v2[0] * v2[0] + v2[1] * v2[1] + v2[2] * v2[2] + v2[3] * v2[3]) + (v3[0] * v3[0] + v3[1] * v3[1] + v3[2] * v3[2] + v3[3] * v3[3]);
        const float rstd = 1.0f / sqrtf(wave_sum(q) * (1.0f / D) + 1e-5f);
        v0 = v0 * rstd * g0 + b0; v1 = v1 * rstd * g1 + b1; v2 = v2 * rstd * g2 + b2; v3 = v3 * rstd * g3 + b3;
        f32x4* xo = (f32x4*)(XF + (size_t)m * D) + c.lane; xo[0] = v0; xo[64] = v1; xo[128] = v2; xo[192] = v3;
        u32x2* bo = (u32x2*)(XB + (size_t)m * D) + c.lane; u32x2 o;
        o.x = cvt_pk_bf16(v0[0], v0[1]); o.y = cvt_pk_bf16(v0[2], v0[3]); bo[0] = o;
        o.x = cvt_pk_bf16(v1[0], v1[1]); o.y = cvt_pk_bf16(v1[2], v1[3]); bo[64] = o;
        o.x = cvt_pk_bf16(v2[0], v2[1]); o.y = cvt_pk_bf16(v2[2], v2[3]); bo[128] = o;
        o.x = cvt_pk_bf16(v3[0], v3[1]); o.y = cvt_pk_bf16(v3[2], v3[3]); bo[192] = o;
    }
}
DI float zshift(const bf16_t* ZRW, size_t t, int tin, int col, const float* mu) {
    const float z = bf2f(ZRW[t * 2048 + col]); const float zp = tin ? bf2f(ZRW[(t - 1) * 2048 + col]) : 0.f;
    return z + (zp - z) * mu[col];
}
DI void prep_lora_a(const Ctx& c, const bf16_t* ZRW, const float* mu, bf16_t* LA) {
    for (int i = c.gtid; i < M * (KL / 8); i += c.NGT) {
        const int t = i / (KL / 8), g = i % (KL / 8); u32x4 o = (u32x4){0u, 0u, 0u, 0u};
        if (g < 36) {
            const int col = 1536 + 8 * g;
            const u32x4 zc = *(const u32x4*)(ZRW + (size_t)t * 2048 + col); u32x4 zp = (u32x4){0u, 0u, 0u, 0u};
            if (t & (SEQ - 1)) zp = *(const u32x4*)(ZRW + (size_t)(t - 1) * 2048 + col);
            const f32x4 m0 = *(const f32x4*)(mu + col), m1 = *(const f32x4*)(mu + col + 4);
            float r[8];
#pragma unroll
            for (int e = 0; e < 8; ++e) {
                const unsigned zw = zc[e >> 1], pw = zp[e >> 1];
                const float z = (e & 1) ? __uint_as_float(zw & 0xffff0000u) : __uint_as_float(zw << 16), pz = (e & 1) ? __uint_as_float(pw & 0xffff0000u) : __uint_as_float(pw << 16);
                const float m = e < 4 ? m0[e & 3] : m1[e & 3]; const float s = z + (pz - z) * m;
                r[e] = g < 8 ? 1.0f - 2.0f / (1.0f + __expf(2.0f * s)) : (g < 16 ? s : sigmoidf_(s));
            }
            o.x = cvt_pk_bf16(r[0], r[1]); o.y = cvt_pk_bf16(r[2], r[3]); o.z = cvt_pk_bf16(r[4], r[5]); o.w = cvt_pk_bf16(r[6], r[7]);
        }
        *(u32x4*)(LA + (size_t)t * KL + 8 * g) = o;
    }
}
DI float ret_lg2(int h) { return log1pf(-exp2f(-5.0f - (float)h)) * 1.4426950408889634f; }
DI void ret_kv(const Ctx& c, const bf16_t* ZRET, float* KV) {
    typedef pg8::bf16x8 bf16x8;
    const int w = c.wave, lane = c.lane, fr = lane & 15, fq = lane >> 4, dt = w >> 1, et0 = (w & 1) * 2;
    LAS unsigned char* L = c.lds;
    constexpr int OKT = 0, OVT = 17408;
    for (int u = c.bx; u < 1024; u += c.G) {
        const int bh = u >> 5, n = u & 31, b = bh >> 3, h = bh & 7; const float lg2 = ret_lg2(h);
        const bf16_t* zb = ZRET + ((size_t)b * SEQ + n * 128) * 2048 + h * 64;
#pragma unroll
        for (int x = 0; x < 2; ++x) {
            const int g = c.tid + 512 * x, j = g >> 3, dg = (g & 7) * 8; const bf16_t* p = zb + (size_t)j * 2048 + dg;
            const u32x4 rk = *(const u32x4*)(p + 512), rv = *(const u32x4*)(p + 1024);
            const float dj = exp2f((float)(127 - j) * lg2);
#pragma unroll
            for (int i = 0; i < 8; ++i) {
                const unsigned kw = (rk[i >> 1] >> (16 * (i & 1))) & 0xffffu, vw = (rv[i >> 1] >> (16 * (i & 1))) & 0xffffu;
                *(LAS bf16_t*)(L + OKT + (dg + i) * 272 + j * 2) = f2bf(bf2f((bf16_t)kw) * dj);
                *(LAS bf16_t*)(L + OVT + (dg + i) * 272 + j * 2) = (bf16_t)vw;
            }
        }
        __syncthreads();
        f32x4 sacc[2]; sacc[0] = (f32x4){0.f, 0.f, 0.f, 0.f}; sacc[1] = sacc[0];
#pragma unroll
        for (int ks = 0; ks < 4; ++ks) { const bf16x8 ka = *(const LAS bf16x8*)(L + OKT + (16 * dt + fr) * 272 + (ks * 32 + fq * 8) * 2);
#pragma unroll
            for (int x = 0; x < 2; ++x) { const bf16x8 vb = *(const LAS bf16x8*)(L + OVT + (16 * (et0 + x) + fr) * 272 + (ks * 32 + fq * 8) * 2); sacc[x] = __builtin_amdgcn_mfma_f32_16x16x32_bf16(ka, vb, sacc[x], 0, 0, 0); } }
        float* kvo = KV + (size_t)u * 4096;
#pragma unroll
        for (int x = 0; x < 2; ++x) *(f32x4*)(kvo + (16 * (et0 + x) + fr) * 64 + 16 * dt + fq * 4) = sacc[x];
        __syncthreads();
    }
}
DI void ret_prefix(const Ctx& c, const float* KV, bf16_t* PS) {
    for (int idx = c.gtid; idx < 32 * 4096; idx += c.NGT) {
        const int bh = idx >> 12, e = (idx >> 6) & 63, d = idx & 63; const float cdec = exp2f(128.0f * ret_lg2(bh & 7));
        float st = 0.f;
        float kv[8];
        for (int n0 = 0; n0 < 32; n0 += 8) {
#pragma unroll
            for (int j = 0; j < 8; ++j) kv[j] = KV[(size_t)(bh * 32 + n0 + j) * 4096 + e * 64 + d];
#pragma unroll
            for (int j = 0; j < 8; ++j) { PS[(size_t)(bh * 32 + n0 + j) * 4096 + e * 64 + d] = f2bf(st); st = st * cdec + kv[j]; }
        }
    }
}
DI void ret_out(const Ctx& c, const bf16_t* ZRET, const bf16_t* PS, const float* gn_g, const float* gn_b, bf16_t* MIX) {
    typedef pg8::bf16x8 bf16x8;
    const int w = c.wave, lane = c.lane, fr = lane & 15, fq = lane >> 4, i0 = 16 * w;
    LAS unsigned char* L = c.lds;
    constexpr int OQ = 0, OKS = 18432, OVT = 36864, OP = 54272;
    LAS unsigned char* Pw = L + OP + w * 4352;
    u32x4 rq[2], rk[2], rv[2], rg[2];
    constexpr int OG = 89088;
#define RET_LOAD(u_) do { const int bh_ = (u_) >> 5, n_ = (u_) & 31; const bf16_t* zb_ = ZRET + ((size_t)(bh_ >> 3) * SEQ + n_ * 128) * 2048 + (bh_ & 7) * 64; \
        _Pragma("unroll") for (int x = 0; x < 2; ++x) { const int g = c.tid + 512 * x, j = g >> 3, dg = (g & 7) * 8; const bf16_t* p = zb_ + (size_t)j * 2048 + dg; \
        rq[x] = *(const u32x4*)p; rk[x] = *(const u32x4*)(p + 512); rv[x] = *(const u32x4*)(p + 1024); rg[x] = *(const u32x4*)(p + 1536); } } while (0)
    if (c.bx < 1024) RET_LOAD(c.bx);
    for (int u = c.bx; u < 1024; u += c.G) {
        const int bh = u >> 5, n = u & 31, b = bh >> 3, h = bh & 7; const float lg2 = ret_lg2(h);
#pragma unroll
        for (int x = 0; x < 2; ++x) {
            const int g = c.tid + 512 * x, j = g >> 3, dg = (g & 7) * 8;
            *(LAS u32x4*)(L + OQ + j * 144 + dg * 2) = rq[x]; *(LAS u32x4*)(L + OKS + j * 144 + dg * 2) = rk[x]; *(LAS u32x4*)(L + OG + j * 144 + dg * 2) = rg[x];
#pragma unroll
            for (int i = 0; i < 8; ++i) *(LAS bf16_t*)(L + OVT + (dg + i) * 272 + j * 2) = (bf16_t)((rv[x][i >> 1] >> (16 * (i & 1))) & 0xffffu);
        }
        if (u + c.G < 1024) RET_LOAD(u + c.G);
        const size_t t0 = (size_t)b * SEQ + n * 128 + i0 + fq * 4;
        bf16x8 sb[2][4];
#pragma unroll
        for (int ks = 0; ks < 2; ++ks)
#pragma unroll
            for (int et = 0; et < 4; ++et) sb[ks][et] = *(const bf16x8*)(PS + (size_t)u * 4096 + (16 * et + fr) * 64 + ks * 32 + fq * 8);
        float gg[4], gb[4];
#pragma unroll
        for (int et = 0; et < 4; ++et) { gg[et] = gn_g[h * 64 + 16 * et + fr]; gb[et] = gn_b[h * 64 + 16 * et + fr]; }
        __syncthreads();
        bf16x8 qa[2];
#pragma unroll
        for (int ks = 0; ks < 2; ++ks) qa[ks] = *(const LAS bf16x8*)(L + OQ + (i0 + fr) * 144 + (ks * 32 + fq * 8) * 2);
#pragma unroll
        for (int jt = 0; jt < 8; ++jt) {
            f32x4 sc = (f32x4){0.f, 0.f, 0.f, 0.f};
#pragma unroll
            for (int ks = 0; ks < 2; ++ks) { const bf16x8 kb = *(const LAS bf16x8*)(L + OKS + (16 * jt + fr) * 144 + (ks * 32 + fq * 8) * 2); sc = __builtin_amdgcn_mfma_f32_16x16x32_bf16(qa[ks], kb, sc, 0, 0, 0); }
#pragma unroll
            for (int r = 0; r < 4; ++r) { const int di = (i0 + fq * 4 + r) - (16 * jt + fr); const float pv = di >= 0 ? sc[r] * exp2f((float)di * lg2) : 0.f;
                *(LAS bf16_t*)(Pw + (fq * 4 + r) * 272 + (16 * jt + fr) * 2) = f2bf(pv); }
        }
        f32x4 o[4], cr[4];
#pragma unroll
        for (int et = 0; et < 4; ++et) { o[et] = (f32x4){0.f, 0.f, 0.f, 0.f}; cr[et] = o[et]; }
#pragma unroll
        for (int ks = 0; ks < 4; ++ks) { const bf16x8 pa = *(const LAS bf16x8*)(Pw + fr * 272 + (ks * 32 + fq * 8) * 2);
#pragma unroll
            for (int et = 0; et < 4; ++et) { const bf16x8 vb = *(const LAS bf16x8*)(L + OVT + (16 * et + fr) * 272 + (ks * 32 + fq * 8) * 2); o[et] = __builtin_amdgcn_mfma_f32_16x16x32_bf16(pa, vb, o[et], 0, 0, 0); } }
#pragma unroll
        for (int ks = 0; ks < 2; ++ks)
#pragma unroll
            for (int et = 0; et < 4; ++et) cr[et] = __builtin_amdgcn_mfma_f32_16x16x32_bf16(qa[ks], sb[ks][et], cr[et], 0, 0, 0);
#pragma unroll
        for (int r = 0; r < 4; ++r) {
            const int i = i0 + fq * 4 + r; const float qd = exp2f((float)(i + 1) * lg2);
            float v[4]; float s = 0.f;
#pragma unroll
            for (int et = 0; et < 4; ++et) { v[et] = o[et][r] + cr[et][r] * qd; s += v[et]; }
            const float mean = red16(s) * (1.0f / 64.0f); float q = 0.f;
#pragma unroll
            for (int et = 0; et < 4; ++et) { v[et] -= mean; q += v[et] * v[et]; }
            const float rstd = 1.0f / sqrtf(red16(q) * (1.0f / 64.0f) + 1e-5f);
#pragma unroll
            for (int et = 0; et < 4; ++et) { const float g = bf2f(*(const LAS bf16_t*)(L + OG + i * 144 + (16 * et + fr) * 2));
                *(LAS bf16_t*)(L + OQ + i * 144 + (16 * et + fr) * 2) = f2bf(g * sigmoidf_(g) * (v[et] * rstd * gg[et] + gb[et])); }
        }
        asm volatile("s_waitcnt lgkmcnt(0)" ::: "memory");
#pragma unroll
        for (int x = 0; x < 2; ++x) { const int rr = lane >> 2, ch = (lane & 3) * 2 + x;
            const u32x4 ov = *(const LAS u32x4*)(L + OQ + (i0 + rr) * 144 + ch * 16);
            *(u32x4*)(MIX + ((size_t)b * SEQ + n * 128 + i0 + rr) * D + h * 64 + ch * 8) = ov; }
        __syncthreads();
    }
#undef RET_LOAD
}
struct SideP { const bf16_t* ZRW; const float* LW; const bf16_t* LA2; const bf16_t* LG; const float* mu; const float* k_k; const float* k_a; const float* r_k; const float* gn_g; const float* gn_b; bf16_t* MIX; };
DI void rounds_side(int bh, int tl_first, int tstep, int lane, int p, const SideP& P, float* SC, const float* YB) {
    const int b = bh >> 3, h = bh & 7, hc = h * 64 + lane;
    const float mu_r = P.mu[hc], mu_k = P.mu[512 + hc], mu_v = P.mu[1024 + hc], kkc = P.k_k[hc], kac = P.k_a[hc], rkc = P.r_k[hc], gg = P.gn_g[hc], gb = P.gn_b[hc];
    const bool do_post = p >= 2, do_prep = p < NR;
    for (int tl0 = tl_first; tl0 < TR; tl0 += 4 * tstep) {
        float pr[4], pk[4], pv[4], py[4], pg[4];
        float z0[4], z1[4], z2[4], q0[4], q1[4], q2[4], lw[4], la[4];
        if (do_post) {
#pragma unroll
            for (int j = 0; j < 4; ++j) { const int tl = tl0 + tstep * j; if (tl >= TR) continue; const size_t t = (size_t)b * SEQ + (p - 2) * TR + tl; const float* rec = SC + ((size_t)bh * TR + tl) * REC + lane;
                pr[j] = rec[0]; pk[j] = rec[128]; pv[j] = rec[320]; py[j] = YB[((size_t)bh * TR + tl) * 64 + lane]; pg[j] = bf2f(P.LG[t * 512 + hc]); }
        }
        if (do_prep) {
#pragma unroll
            for (int j = 0; j < 4; ++j) { if (tl0 + tstep * j >= TR) continue; const int tin = p * TR + tl0 + tstep * j; const size_t t = (size_t)b * SEQ + tin; const bf16_t* zr = P.ZRW + t * 2048 + hc;
                z0[j] = bf2f(zr[0]); z1[j] = bf2f(zr[512]); z2[j] = bf2f(zr[1024]);
                if (tin) { q0[j] = bf2f(zr[-2048]); q1[j] = bf2f(zr[512 - 2048]); q2[j] = bf2f(zr[1024 - 2048]); } else { q0[j] = 0.f; q1[j] = 0.f; q2[j] = 0.f; }
                lw[j] = P.LW[t * 512 + hc]; la[j] = bf2f(P.LA2[t * 512 + hc]); }
        }
        if (do_post) {
#pragma unroll
            for (int j = 0; j < 4; ++j) { const int tl = tl0 + tstep * j; if (tl >= TR) continue; const size_t t = (size_t)b * SEQ + (p - 2) * TR + tl;
                const float mean = wave_sum(py[j]) * (1.0f / 64.0f); const float dv = py[j] - mean; const float var = wave_sum(dv * dv) * (1.0f / 64.0f);
                const float yn = dv * (1.0f / sqrtf(var + 64e-5f)) * gg + gb; const float bonus = wave_sum(pr[j] * pk[j] * rkc) * pv[j];
                P.MIX[t * D + 512 + hc] = f2bf((yn + bonus) * pg[j]); }
        }
        if (do_prep) {
#pragma unroll
            for (int j = 0; j < 4; ++j) { const int tl = tl0 + tstep * j; if (tl >= TR) continue;
                const float r = z0[j] + (q0[j] - z0[j]) * mu_r, kr = z1[j] + (q1[j] - z1[j]) * mu_k, v = z2[j] + (q2[j] - z2[j]) * mu_v;
                const float w = decay_from_lora(lw[j]), a = sigmoidf_(la[j]);
                float kk = kr * kkc; const float n2 = wave_sum(kk * kk); kk = kk / fmaxf(sqrtf(n2), 1e-12f);
                float* rec = SC + ((size_t)bh * TR + tl) * REC + lane;
                rec[0] = r; rec[64] = w; rec[128] = kr * (1.0f + (a - 1.0f) * kac); rec[192] = kk; rec[256] = -(kk * a); rec[320] = v; }
        }
    }
}
struct StepIn { f32x4 r, w, k, kk, b; float v; };
DI float fma_(float a, float b, float c) { float d; asm("v_fma_f32 %0, %1, %2, %3" : "=v"(d) : "v"(a), "v"(b), "v"(c)); return d; }
DI float nfma_(float a, float b, float c) { float d; asm("v_fma_f32 %0, -%1, %2, %3" : "=v"(d) : "v"(a), "v"(b), "v"(c)); return d; }
DI float mul_(float a, float b) { float d; asm("v_mul_f32 %0, %1, %2" : "=v"(d) : "v"(a), "v"(b)); return d; }
#define RING_NB 4
DI unsigned lds_ld(volatile LAS unsigned* p) { return __hip_atomic_load((LAS unsigned*)p, __ATOMIC_RELAXED, __HIP_MEMORY_SCOPE_WORKGROUP); }
DI void lds_st(volatile LAS unsigned* p, unsigned v) { __hip_atomic_store((LAS unsigned*)p, v, __ATOMIC_RELAXED, __HIP_MEMORY_SCOPE_WORKGROUP); }
DI int scan_bh(int bx) { return (bx & 7) * 4 + (bx >> 6); }
DI void scan_loader(const Ctx& c, int round, const float* SC, volatile LAS unsigned* ctl) {
    const float* rec0 = SC + (size_t)scan_bh(c.bx) * TR * REC;
    const unsigned gb0 = (unsigned)round * (TR / 16);
    for (int blk = 0; blk < TR / 16; ++blk) {
        const unsigned gb = gb0 + blk;
        if (gb >= RING_NB) { while (min(lds_ld(ctl + 1), lds_ld(ctl + 2)) + RING_NB <= gb) __builtin_amdgcn_s_sleep(1); }
        asm volatile("" ::: "memory");
        LAS unsigned char* dst = c.lds + (gb % RING_NB) * 24576;
#pragma unroll
        for (int q = 0; q < 24; ++q)
            __builtin_amdgcn_global_load_lds((const unsigned*)(rec0 + (size_t)blk * 16 * REC + (q * 64 + c.lane) * 4), (LAS unsigned*)(dst + q * 1024), 16, 0, 0);
        if (blk > 0) { asm volatile("s_waitcnt vmcnt(24)" ::: "memory"); lds_st(ctl, gb); }
    }
    asm volatile("s_waitcnt vmcnt(0)" ::: "memory"); lds_st(ctl, gb0 + TR / 16);
}
DI void scan_round(const Ctx& c, int sw, int round, float* YB, float* ST, volatile LAS unsigned* ctl, bool keep = true) {
    const int bh = scan_bh(c.bx), rg = ((c.bx >> 3) & 7) * 2 + sw, kq = c.lane & 15, row = rg * 4 + (c.lane >> 4);
    float* y0 = YB + (size_t)bh * TR * 64;
    float* stp = ST + ((size_t)bh * 64 + row) * 64 + kq * 4;
    f32x4 S = (f32x4){0.f, 0.f, 0.f, 0.f};
    if (round) S = *(const f32x4*)stp;
    const unsigned gb0 = (unsigned)round * (TR / 16);
#define SCAN_LD(dst, s) do { const LAS unsigned char* ps_ = p + (s) * 1536; dst.r = *(const LAS f32x4*)(ps_ + kq * 16); dst.w = *(const LAS f32x4*)(ps_ + 256 + kq * 16); dst.k = *(const LAS f32x4*)(ps_ + 512 + kq * 16); \
        dst.kk = *(const LAS f32x4*)(ps_ + 768 + kq * 16); dst.b = *(const LAS f32x4*)(ps_ + 1024 + kq * 16); dst.v = *(const LAS float*)(ps_ + 1280 + row * 4); } while (0)
    unsigned seen = lds_ld(ctl);
    for (int blk = 0; blk < TR / 16; ++blk) {
        const unsigned gb = gb0 + blk;
        while (seen <= gb) { __builtin_amdgcn_s_sleep(1); seen = lds_ld(ctl); }
        asm volatile("" ::: "memory");
        const LAS unsigned char* p = c.lds + (gb % RING_NB) * 24576;
        float yp[16];
        StepIn cur, nxt, nx2; SCAN_LD(cur, 0); SCAN_LD(nxt, 1);
        f32x4 rprev = cur.r;
#pragma unroll
        for (int s = 0; s < 16; ++s) {
            if (s < 14) SCAN_LD(nx2, s + 2);
            if (s == 8) seen = lds_ld(ctl);
            float sa; { float a0 = mul_(S[0], cur.kk[0]), a1 = mul_(S[2], cur.kk[2]); a0 = fma_(S[1], cur.kk[1], a0); a1 = fma_(S[3], cur.kk[3], a1); asm("v_add_f32 %0, %1, %2" : "=v"(sa) : "v"(a0), "v"(a1)); }
            if (s > 0) { float y = S[0] * rprev[0]; y = fmaf(S[1], rprev[1], y); y = fmaf(S[2], rprev[2], y); y = fmaf(S[3], rprev[3], y); yp[s - 1] = y; }
            const f32x4 T = S * cur.w + cur.k * cur.v;
            sa = red16(sa);
            S = T + cur.b * sa;
            rprev = cur.r;
            if (s < 15) cur = nxt;
            if (s < 14) nxt = nx2;
        }
        { float y = S[0] * rprev[0]; y = fmaf(S[1], rprev[1], y); y = fmaf(S[2], rprev[2], y); y = fmaf(S[3], rprev[3], y); yp[15] = y; }
        float yk;
        {
            const bool b3 = (kq & 8) != 0, b2 = (kq & 4) != 0, b1 = (kq & 2) != 0, b0 = (kq & 1) != 0;
            float q8[8], q4[4], q2[2];
#pragma unroll
            for (int j = 0; j < 8; ++j) { const float keep = b3 ? yp[j + 8] : yp[j], send = b3 ? yp[j] : yp[j + 8]; q8[j] = keep + dpp_f<0x128>(send); }
#pragma unroll
            for (int j = 0; j < 4; ++j) { const float keep = b2 ? q8[j + 4] : q8[j], send = b2 ? q8[j] : q8[j + 4]; q4[j] = keep + dpp_f<0x141>(send); }
#pragma unroll
            for (int j = 0; j < 2; ++j) { const float keep = b1 ? q4[j + 2] : q4[j], send = b1 ? q4[j] : q4[j + 2]; q2[j] = keep + dpp_f<0x4E>(send); }
            { const float keep = b0 ? q2[1] : q2[0], send = b0 ? q2[0] : q2[1]; yk = keep + dpp_f<0xB1>(send); }
        }
        asm volatile("s_waitcnt lgkmcnt(0)" ::: "memory");
        lds_st(ctl + 1 + sw, gb + 1);
        y0[(size_t)(blk * 16 + kq) * 64 + row] = yk;
    }
#undef SCAN_LD
    if (keep) *(f32x4*)stp = S;
}

#define XB_TMO      128
#define XB_XCNT(j)  (256  + 64 * (j))
#define XB_XSUB(j)  (1280 + 64 * (j))
#define XB_XGEN(j)  (2304 + 64 * (j))
#define XB_TOP      3328
#define XB_TOPGEN   3392
#define XCD_BAR_WORDS 3456
#define XB_SPIN_CAP (1u << 18)

__device__ __forceinline__ unsigned xb_ld(unsigned* p)              { return __hip_atomic_load(p, __ATOMIC_RELAXED, __HIP_MEMORY_SCOPE_AGENT); }
__device__ __forceinline__ unsigned xb_add(unsigned* p, unsigned v) { return __hip_atomic_fetch_add(p, v, __ATOMIC_RELAXED, __HIP_MEMORY_SCOPE_AGENT); }
__device__ __forceinline__ unsigned xb_xcc_id() { return (unsigned)__builtin_amdgcn_s_getreg((3 << 11) | 20) & 0xFu; }
#define XB_SPIN(cond, bar) do { unsigned _sp = 0; while (cond) { __builtin_amdgcn_s_sleep(1); \
    if ((++_sp & 255u) == 0u) { if (xb_ld(&(bar)[XB_TMO])) break; if (_sp > XB_SPIN_CAP) { atomicAdd(&(bar)[XB_TMO], 1u); break; } } } } while (0)

struct XcdBarrier {
    unsigned* bar; unsigned x;
    volatile LAS unsigned* st;
};

__device__ __forceinline__ XcdBarrier xcd_barrier_post(unsigned* bar, volatile LAS unsigned* st) {
    XcdBarrier b; b.bar = bar; b.x = xb_xcc_id(); b.st = st;
    if (threadIdx.x == 0) (void)xb_add(&bar[XB_XCNT(b.x)], 1u);
    return b;
}
__device__ __forceinline__ void xcd_barrier_complete(unsigned* bar, unsigned x, unsigned& nloc, unsigned& nx) {
    const unsigned G = gridDim.x * gridDim.y * gridDim.z;
    unsigned sum, cnt, mine, sp = 0u;
    for (;;) {
        sum = 0u; cnt = 0u; mine = 0u;
#pragma unroll
        for (unsigned j = 0; j < 16; ++j) { const unsigned c = xb_ld(&bar[XB_XCNT(j)]); sum += c; cnt += (c > 0u) ? 1u : 0u; mine = (j == x) ? c : mine; }
        if (sum == G) break;
        __builtin_amdgcn_s_sleep(1);
        if ((++sp & 255u) == 0u) { if (xb_ld(&bar[XB_TMO])) break; if (sp > XB_SPIN_CAP) { atomicAdd(&bar[XB_TMO], 1u); break; } }
    }
    nloc = mine > 0u ? mine : 1u; nx = cnt > 0u ? cnt : 1u;
}

__device__ __forceinline__ void xcd_barrier(const XcdBarrier& b) {
    asm volatile("s_waitcnt vmcnt(0)" ::: "memory");
    __syncthreads();
    if (threadIdx.x == 0) {
        unsigned* bar = b.bar;
        __builtin_amdgcn_s_waitcnt(0);
        unsigned nloc = b.st[0], nx = b.st[1];
        if (nloc == 0u) { xcd_barrier_complete(bar, b.x, nloc, nx); b.st[0] = nloc; b.st[1] = nx; }
        const unsigned old = xb_add(&bar[XB_XSUB(b.x)], 1u);
        const unsigned gen = old / nloc;
        if (old + 1u == (gen + 1u) * nloc) {
            __builtin_amdgcn_fence(__ATOMIC_RELEASE, "agent");
            asm volatile("s_waitcnt vmcnt(0)" ::: "memory");
            const unsigned og = xb_add(&bar[XB_TOP], 1u);
            const unsigned tg = og / nx;
            if (og + 1u == (tg + 1u) * nx) xb_add(&bar[XB_TOPGEN], 1u);
            else XB_SPIN(xb_ld(&bar[XB_TOPGEN]) == tg, bar);
            __builtin_amdgcn_fence(__ATOMIC_ACQUIRE, "agent");
            xb_add(&bar[XB_XGEN(b.x)], 1u);
            asm volatile("s_waitcnt vmcnt(0)" ::: "memory");
        } else {
            XB_SPIN(xb_ld(&bar[XB_XGEN(b.x)]) == gen, bar);
            __builtin_amdgcn_fence(__ATOMIC_ACQUIRE, "agent");
            asm volatile("s_waitcnt vmcnt(0)" ::: "memory");
        }
    }
    __syncthreads();
}

struct Args { const float* in[30]; float* out; unsigned char* ws; int ph_lo, ph_hi; };
enum { I_X = 0, I_P, I_F1GU, I_F1D, I_LN1G, I_LN1B, I_WIN, I_RGNG, I_RGNB, I_MU, I_W0, I_WUP, I_A0, I_AUP, I_GUP, I_KK, I_KA, I_RK, I_WGNG, I_WGNB, I_WOUT, I_LN2G, I_LN2B,
       I_F2GU, I_F2D, I_LN3G, I_LN3B, I_PPROJ, I_PGATE, I_PBIAS };

#define CAS __attribute__((address_space(4)))
#define PHASE_BEGIN(k) if (ph_lo <= (k) && (k) < ph_hi) { \
        int tid_ = threadIdx.x; asm volatile("" : "+v"(tid_)); \
        Ctx c; c.lds = (LAS unsigned char*)lds_raw; c.tid = tid_; c.lane = c.tid & 63; c.wave = __builtin_amdgcn_readfirstlane(c.tid >> 6); \
        c.bx = blockIdx.x; c.G = gridDim.x; c.gw = c.bx * 8 + c.wave; c.NGW = c.G * 8; c.gtid = c.bx * 512 + c.tid; c.NGT = c.G * 512; \
        const CAS Args* ap = (const CAS Args*)__builtin_amdgcn_kernarg_segment_ptr(); asm volatile("" : "+s"(ap)); const CAS Args& a = *ap; unsigned char* ws = a.ws; (void)ws;
#define PHASE_END(k) if ((k) + 1 < ph_hi) xcd_barrier(bar); }
#define P_(T, name, off) T* name = (T*)(ws + (off))

#define GEMM_GU(Aptr, statp, c1p, c2p) do { P_(bf16_t, Wgu_t, WS_WGU); P_(bf16_t, H, WS_A); \
        pg8::Gemm g{Aptr, Wgu_t, M, NGU, D}; pg8::StaticOrder S; S.init(M, NGU, c.G, c.bx); EpiGU E{H, statp, c1p, c2p}; \
        pg8::gemm_phase<EpiGU, pg8::StaticOrder, PG_ALIGN, true>(c.lds, g, S, E, c.tid); } while (0)
#define GEMM_RES(Aptr, Wptr, Kdim, Xraw, Yio, YBp, stat_out, ln_stat, lng, lnb, scale) do { \
        pg8::Gemm g{Aptr, Wptr, M, D, Kdim}; pg8::StaticOrder S; S.init(M, D, c.G, c.bx); EpiRes E{Xraw, Yio, YBp, stat_out, ln_stat, lng, lnb, scale}; \
        pg8::gemm_phase<EpiRes, pg8::StaticOrder, PG_ALIGN, true>(c.lds, g, S, E, c.tid); } while (0)
DI void ln_tail(const Ctx& c, int inst, const float* Y, const float* g, const float* b, float* XF, bf16_t* XB, unsigned* cnt_base) {
    pg8::StaticOrder S; S.init(M, D, c.G, c.bx); pg8::Unit u;
    if (!S.next(0, u)) return;
    unsigned* cnt = cnt_base + inst * 64 + u.pm;
    asm volatile("s_waitcnt vmcnt(0)" ::: "memory");
    __syncthreads();
    if (c.tid == 0) {
        __builtin_amdgcn_fence(__ATOMIC_RELEASE, "agent");
        asm volatile("s_waitcnt vmcnt(0)" ::: "memory");
        __hip_atomic_fetch_add(cnt, 1u, __ATOMIC_RELAXED, __HIP_MEMORY_SCOPE_AGENT);
        unsigned sp = 0;
        while (__hip_atomic_load(cnt, __ATOMIC_RELAXED, __HIP_MEMORY_SCOPE_AGENT) < 4u) { __builtin_amdgcn_s_sleep(1); if (++sp > (1u << 22)) break; }
        __builtin_amdgcn_fence(__ATOMIC_ACQUIRE, "agent");
        asm volatile("s_waitcnt vmcnt(0)" ::: "memory");
    }
    __syncthreads();
    const int lane = c.lane;
    const f32x4 g0 = ((const f32x4*)g)[lane], g1 = ((const f32x4*)g)[lane + 64], g2 = ((const f32x4*)g)[lane + 128], g3 = ((const f32x4*)g)[lane + 192];
    const f32x4 b0 = ((const f32x4*)b)[lane], b1 = ((const f32x4*)b)[lane + 64], b2 = ((const f32x4*)b)[lane + 128], b3 = ((const f32x4*)b)[lane + 192];
    for (int rr = c.wave; rr < 64; rr += 8) {
        const int m = u.pm * 256 + u.pn * 64 + rr;
        const f32x4* yr = (const f32x4*)(Y + (size_t)m * D) + lane;
        f32x4 v0 = yr[0], v1 = yr[64], v2 = yr[128], v3 = yr[192];
        float sm = (v0[0] + v0[1] + v0[2] + v0[3]) + (v1[0] + v1[1] + v1[2] + v1[3]) + (v2[0] + v2[1] + v2[2] + v2[3]) + (v3[0] + v3[1] + v3[2] + v3[3]);
        const float mean = wave_sum(sm) * (1.0f / D);
        v0 = v0 - mean; v1 = v1 - mean; v2 = v2 - mean; v3 = v3 - mean;
        float q = (v0[0] * v0[0] + v0[1] * v0[1] + v0[2] * v0[2] + v0[3] * v0[3]) + (v1[0] * v1[0] + v1[1] * v1[1] + v1[2] * v1[2] + v1[3] * v1[3])
                + (v2[0] * v2[0] + v2[1] * v2[1] + v2[2] * v2[2] + v2[3] * v2[3]) + (v3[0] * v3[0] + v3[1] * v3[1] + v3[2] * v3[2] + v3[3] * v3[3]);
        const float rstd = 1.0f / sqrtf(wave_sum(q) * (1.0f / D) + 1e-5f);
        v0 = v0 * rstd * g0 + b0; v1 = v1 * rstd * g1 + b1; v2 = v2 * rstd * g2 + b2; v3 = v3 * rstd * g3 + b3;
        f32x4* xo = (f32x4*)(XF + (size_t)m * D) + lane; xo[0] = v0; xo[64] = v1; xo[128] = v2; xo[192] = v3;
        u32x2* bo = (u32x2*)(XB + (size_t)m * D) + lane; u32x2 o;
        o.x = cvt_pk_bf16(v0[0], v0[1]); o.y = cvt_pk_bf16(v0[2], v0[3]); bo[0] = o;
        o.x = cvt_pk_bf16(v1[0], v1[1]); o.y = cvt_pk_bf16(v1[2], v1[3]); bo[64] = o;
        o.x = cvt_pk_bf16(v2[0], v2[1]); o.y = cvt_pk_bf16(v2[2], v2[3]); bo[128] = o;
        o.x = cvt_pk_bf16(v3[0], v3[1]); o.y = cvt_pk_bf16(v3[2], v3[3]); bo[192] = o;
    }
}
#define LN_TAIL(inst, gi) do { P_(float, Yt, WS_B); P_(bf16_t, XBt, WS_XB); ln_tail(c, inst, Yt, a.in[gi], a.in[(gi) + 1], a.out, XBt, (unsigned*)(ws + 14336)); } while (0)
#define LN_ROWS(gi) do { P_(float, Y, WS_B); P_(bf16_t, XB, WS_XB); layer_norm_rows(c, Y, a.in[gi], a.in[(gi) + 1], a.out, XB); if (DUP_MISC > 1) layer_norm_rows(c, Y, a.in[gi], a.in[(gi) + 1], a.out, XB); } while (0)

__global__ void __launch_bounds__(512, 2) mk_fwd(Args a_kernarg) {
    extern __shared__ __attribute__((aligned(16))) unsigned char lds_raw[];
    cg::grid_group grid = cg::this_grid();
    const int ph_lo = ((const CAS Args*)__builtin_amdgcn_kernarg_segment_ptr())->ph_lo, ph_hi = ((const CAS Args*)__builtin_amdgcn_kernarg_segment_ptr())->ph_hi;
    if (threadIdx.x < 32) ((volatile LAS unsigned*)((LAS unsigned char*)lds_raw + 135 * 1024))[threadIdx.x] = 0u;
    __syncthreads();
    XcdBarrier bar; bar.bar = nullptr; bar.x = 0; bar.st = nullptr;
    if (ph_hi - ph_lo > 1) bar = xcd_barrier_post((unsigned*)((const CAS Args*)__builtin_amdgcn_kernarg_segment_ptr())->ws, (volatile LAS unsigned*)((LAS unsigned char*)lds_raw + 135 * 1024));
    if (ph_hi > NPH) grid.sync();
    constexpr int PH_ROUND0 = 8, PH_WOUT = 8 + NR + 2;

    PHASE_BEGIN(0)
        P_(bf16_t, Wgu_t, WS_WGU); P_(bf16_t, Wd_t, WS_WD); P_(bf16_t, XB, WS_XB);
        { LAS float* scr0 = (LAS float*)(c.lds + c.wave * 8448);
          for (int it = c.gw; it < 2816; it += c.NGW) { const int kb = it / 176, nb = it % 176; transpose_item(a.in[I_F1GU], NGU, Wgu_t, D, gu_dst_row(32 * nb), 64 * kb, 32 * nb, scr0, c.lane); } }
        for (int i = c.gtid; i < (int)((WS_ZERO_BYTES - WS_C1WIN) / 16); i += c.NGT) ((u32x4*)(ws + WS_C1WIN))[i] = (u32x4){0u, 0u, 0u, 0u};
        cvt_rows_bf16(c, a.in[I_X], XB, (size_t)M * D / 4);
    PHASE_END(0)
#define RSTAT(i) ((float*)(ws + WS_RSTAT) + (size_t)(i) * 2 * M)
    PHASE_BEGIN(1) {
        { P_(bf16_t, XB, WS_XB); GEMM_GU(XB, (const float*)nullptr, (const float*)nullptr, (const float*)nullptr); }
        if (c.bx >= c.G / 2) {
            P_(bf16_t, Win_t, WS_WIN); P_(bf16_t, Wlora_t, WS_WLORA); P_(bf16_t, Wout_t, WS_WOUT); P_(float, CS, WS_CS);
            const int gw2 = (c.bx - c.G / 2) * 8 + c.wave, ngw2 = (c.G / 2) * 8, gt2 = (c.bx - c.G / 2) * 512 + c.tid, ngt2 = (c.G / 2) * 512;
            LAS float* scr = (LAS float*)(c.lds + c.wave * 8448);
            { P_(bf16_t, Wd_t, WS_WD); for (int it = gw2; it < 1408; it += ngw2) { const int kb = it / 32, nb = it % 32; transpose_item(a.in[I_F1D], D, Wd_t, FF, 32 * nb, 64 * kb, 32 * nb, scr, c.lane); } }
            for (int it = gw2; it < 1936 + 512; it += ngw2) {
                if (it < 1936) { const int kb = it / 121, nb = it % 121; transpose_item(a.in[I_WIN], NIN, Win_t, D, win_dst_row(32 * nb), 64 * kb, 32 * nb, scr, c.lane, a.in[I_LN1G], a.in[I_LN1B], (float*)(ws + WS_C1WIN), (float*)(ws + WS_C2WIN)); }
                else { const int r = it - 1936, kb = r / 32, nb = r % 32; transpose_item(a.in[I_WOUT], D, Wout_t, D, 32 * nb, 64 * kb, 32 * nb, scr, c.lane); }
            }
            for (int i = gt2; i < (NINP - NIN) * D / 8; i += ngt2) ((u32x4*)(Win_t + (size_t)NIN * D))[i] = (u32x4){0u, 0u, 0u, 0u};
            for (int i = gt2; i < NL * (KL / 8); i += ngt2) {
                const int kg = i / NL, n = i % NL, k0 = 8 * kg; u32x4 o = (u32x4){0u, 0u, 0u, 0u};
                const float* src = nullptr;
                if (n < 512) { if (k0 < 64) src = a.in[I_WUP] + (size_t)k0 * 512 + n; }
                else if (n < 1024) { if (k0 >= 64 && k0 < 128) src = a.in[I_AUP] + (size_t)(k0 - 64) * 512 + (n - 512); }
                else { if (k0 >= 128 && k0 < 288) src = a.in[I_GUP] + (size_t)(k0 - 128) * 512 + (n - 1024); }
                if (src) { o.x = cvt_pk_bf16(src[0], src[512]); o.y = cvt_pk_bf16(src[1024], src[1536]); o.z = cvt_pk_bf16(src[2048], src[2560]); o.w = cvt_pk_bf16(src[3072], src[3584]); }
                *(u32x4*)(Wlora_t + (size_t)n * KL + k0) = o;
            }
            for (int i = gt2; i < SEQ * 32; i += ngt2) {
                const int pos = i >> 5, f = i & 31; double pw = 1.0; for (int j = 0; j < f; ++j) pw *= 0.7498942093324559;
                const float invf = (float)pw; const float ang = (float)pos * invf;
                double r = (double)ang; r -= 6.283185307179586 * __builtin_rint(r * 0.15915494309189535); const double x = r * 0.25, x2 = x * x;
                double sn = x * (1.0 + x2 * (-1.0 / 6 + x2 * (1.0 / 120 + x2 * (-1.0 / 5040 + x2 * (1.0 / 362880 + x2 * (-1.0 / 39916800 + x2 * (1.0 / 6227020800.0)))))));
                double cn = 1.0 + x2 * (-0.5 + x2 * (1.0 / 24 + x2 * (-1.0 / 720 + x2 * (1.0 / 40320 + x2 * (-1.0 / 3628800 + x2 * (1.0 / 479001600.0 + x2 * (-1.0 / 87178291200.0)))))));
                double s2 = 2.0 * sn * cn, c2 = 1.0 - 2.0 * sn * sn; sn = 2.0 * s2 * c2; cn = 1.0 - 2.0 * s2 * s2;
                CS[2 * i] = (float)cn; CS[2 * i + 1] = (float)sn;
            }
        }
    } PHASE_END(1)
    PHASE_BEGIN(2) { P_(bf16_t, H, WS_A); P_(bf16_t, Wd_t, WS_WD); P_(bf16_t, XB, WS_XB);
        GEMM_RES(H, Wd_t, FF, a.in[I_X], a.out, XB, RSTAT(0), (const float*)nullptr, (const float*)nullptr, (const float*)nullptr, 0.5f); } PHASE_END(2)
    PHASE_BEGIN(3) {
        P_(bf16_t, XB, WS_XB); P_(bf16_t, Win_t, WS_WIN); P_(bf16_t, ZRET, WS_A); P_(bf16_t, ZRW, WS_B); P_(float, CS, WS_CS);
        pg8::Gemm g{XB, Win_t, M, NINP, D}; pg8::StaticOrder S; S.init(M, NINP, c.G, c.bx); EpiWin E{ZRET, ZRW, CS, RSTAT(0), (const float*)(ws + WS_C1WIN), (const float*)(ws + WS_C2WIN)};
        pg8::gemm_phase<EpiWin, pg8::StaticOrder, PG_ALIGN, true>(c.lds, g, S, E, c.tid);
    } PHASE_END(3)
    PHASE_BEGIN(4) {
        P_(bf16_t, ZRET, WS_A); P_(bf16_t, ZRW, WS_B); P_(bf16_t, LA, WS_A + 64 * MiB); P_(bf16_t, MIX, WS_XB);
        prep_lora_a(c, ZRW, a.in[I_MU], LA);
#ifdef DUP_PREPA
        prep_lora_a(c, ZRW, a.in[I_MU], LA);
#endif
        { P_(float, KV, WS_SC); ret_kv(c, ZRET, KV); }
    } PHASE_END(4)
    PHASE_BEGIN(5) { P_(float, KV, WS_SC); P_(bf16_t, PS, WS_PB); ret_prefix(c, KV, PS); } PHASE_END(5)
    PHASE_BEGIN(6) { P_(bf16_t, ZRET, WS_A); P_(bf16_t, PS, WS_PB); P_(bf16_t, MIXr, WS_XB); ret_out(c, ZRET, PS, a.in[I_RGNG], a.in[I_RGNB], MIXr); } PHASE_END(6)
    PHASE_BEGIN(7) {
        P_(bf16_t, LA, WS_A + 64 * MiB); P_(bf16_t, Wlora_t, WS_WLORA); P_(float, LW, WS_A); P_(bf16_t, LA2, WS_A + 32 * MiB); P_(bf16_t, LG, WS_A + 48 * MiB);
        int kdim = KL; asm volatile("" : "+s"(kdim)); pg8::Gemm g{LA, Wlora_t, M, NL, kdim}; pg8::StaticOrder S; S.init(M, NL, c.G, c.bx); EpiLora E{LW, LA2, LG, a.in[I_W0], a.in[I_A0]};
        pg8::gemm_phase<EpiLora, pg8::StaticOrder, PG_ALIGN, true>(c.lds, g, S, E, c.tid);
#if DUP_GEMM > 1
        __syncthreads(); pg8::gemm_phase<EpiLora, pg8::StaticOrder, PG_ALIGN, true>(c.lds, g, S, E, c.tid);
#endif
    } PHASE_END(7)
    for (int p = 0; p < NR + 2; ++p) {
        PHASE_BEGIN(PH_ROUND0 + p) {
            P_(float, ST, WS_ST); P_(float, YBA, WS_PB);
            float* SCb[2] = {(float*)(ws + WS_SC), (float*)(ws + WS_A + 64 * MiB)};
            float* SCw = (p & 1) ? SCb[1] : SCb[0]; float* SCr = (p & 1) ? SCb[0] : SCb[1];
            float* YBw = YBA + (size_t)((p & 1) ^ 1) * (32 * TR * 64); float* YBr = YBA + (size_t)(p & 1) * (32 * TR * 64);
            volatile LAS unsigned* ctl = (volatile LAS unsigned*)(c.lds + 135 * 1024 + 64);
            if ((p == 0 || p == NR + 1) && (c.wave == 0 || c.wave == 2 || c.wave == 5)) {
                P_(bf16_t, Wgu_t, WS_WGU); P_(bf16_t, Wd_t, WS_WD);
                LAS float* scr = (LAS float*)(c.lds + c.wave * 8448);
                const int widx = c.bx * 3 + (c.wave == 0 ? 0 : (c.wave == 2 ? 1 : 2)), lo_it = p == 0 ? 0 : 2112, hi_it = p == 0 ? 2112 : 4224;
                for (int it = lo_it + widx; it < hi_it; it += c.G * 3) {
                    if (it < 2816) { const int kb = it / 176, nb = it % 176; transpose_item(a.in[I_F2GU], NGU, Wgu_t, D, gu_dst_row(32 * nb), 64 * kb, 32 * nb, scr, c.lane, a.in[I_LN2G], a.in[I_LN2B], (float*)(ws + WS_C1GU), (float*)(ws + WS_C2GU)); }
                    else { const int r = it - 2816, kb = r / 32, nb = r % 32; transpose_item(a.in[I_F2D], D, Wd_t, FF, 32 * nb, 64 * kb, 32 * nb, scr, c.lane); }
                }
            } else if (c.wave == 0 || c.wave == 5) {
#ifdef DUP_SCAN
                if (p >= 1 && p <= NR) scan_round(c, c.wave ? 1 : 0, p - 1, YBw, ST, ctl, false);
#endif
                __builtin_amdgcn_s_setprio(3);
                if (p >= 1 && p <= NR) scan_round(c, c.wave ? 1 : 0, p - 1, YBw, ST, ctl);
                __builtin_amdgcn_s_setprio(0);
            } else if (c.wave == 2) {
                if (p >= 1 && p <= NR) scan_loader(c, p - 1, SCr, ctl);
            } else {
                P_(bf16_t, ZRW, WS_B); P_(float, LW, WS_A); P_(bf16_t, LA2, WS_A + 32 * MiB); P_(bf16_t, LG, WS_A + 48 * MiB); P_(bf16_t, MIX, WS_XB);
                const int sidx = c.wave == 1 ? 0 : (c.wave == 3 ? 1 : (c.wave == 4 ? 2 : c.wave - 3));
                const int lw = (c.bx >> 3) * 5 + sidx;
                const int sbh = (c.bx & 7) * 4 + (lw & 3), tl_first = lw >> 2, tstep = (c.G >> 3) * 5 / 4;
                SideP SP{ZRW, LW, LA2, LG, a.in[I_MU], a.in[I_KK], a.in[I_KA], a.in[I_RK], a.in[I_WGNG], a.in[I_WGNB], MIX};
                rounds_side(sbh, tl_first, tstep, c.lane, p, SP, SCw, YBr);
            }
        } PHASE_END(PH_ROUND0 + p)
    }
    PHASE_BEGIN(PH_WOUT) {
        { P_(bf16_t, MIX, WS_XB); P_(bf16_t, Wout_t, WS_WOUT); P_(bf16_t, YB2, WS_B);
          GEMM_RES(MIX, Wout_t, D, (const float*)nullptr, a.out, YB2, RSTAT(1), (const float*)RSTAT(0), a.in[I_LN1G], a.in[I_LN1B], 1.0f); }
        { P_(bf16_t, Wpp_t, WS_WPP); P_(bf16_t, PB, WS_PB); LAS float* scr = (LAS float*)(c.lds + c.wave * 8448);
          for (int it = c.gw; it < 128; it += c.NGW) { const int kb = it / 32, nb = it % 32; transpose_item(a.in[I_PPROJ], D, Wpp_t, DP, 32 * nb, 64 * kb, 32 * nb, scr, c.lane); }
          cvt_rows_bf16(c, a.in[I_P], PB, (size_t)M * DP / 4); }
    } PHASE_END(PH_WOUT)
    PHASE_BEGIN(PH_WOUT + 1) {
        { P_(bf16_t, YB2, WS_B); GEMM_GU(YB2, (const float*)RSTAT(1), (const float*)(ws + WS_C1GU), (const float*)(ws + WS_C2GU)); }
        if (c.bx >= c.G / 2) {
            P_(bf16_t, Wpg_t, WS_WPG); P_(bf16_t, Wpp_t, WS_WPP); P_(bf16_t, PB, WS_PB); P_(bf16_t, PROJ, WS_XB);
            const int gw2 = (c.bx - c.G / 2) * 8 + c.wave, ngw2 = (c.G / 2) * 8;
            LAS float* scr = (LAS float*)(c.lds + c.wave * 8448);
            for (int it = gw2; it < 512; it += ngw2) { const int kb = it / 32, nb = it % 32; transpose_item(a.in[I_PGATE], D, Wpg_t, D, 32 * nb, 64 * kb, 32 * nb, scr, c.lane, a.in[I_LN3G], a.in[I_LN3B], (float*)(ws + WS_C1PG), (float*)(ws + WS_C2PG)); }
            __syncthreads();
            { int kdim = DP; asm volatile("" : "+s"(kdim)); const int t3 = launder_v(c.tid); pg8::Gemm g{PB, Wpp_t, M, D, kdim}; pg8::StaticOrder S; S.init(M, D, c.G / 2, c.bx - c.G / 2); EpiProj E{PROJ};
              pg8::gemm_phase<EpiProj, pg8::StaticOrder, PG_ALIGN, true>(c.lds, g, S, E, t3); }
        }
    } PHASE_END(PH_WOUT + 1)
    PHASE_BEGIN(PH_WOUT + 2) { P_(bf16_t, H, WS_A); P_(bf16_t, Wd_t, WS_WD); P_(bf16_t, YB3, WS_B);
        GEMM_RES(H, Wd_t, FF, (const float*)nullptr, a.out, YB3, RSTAT(2), (const float*)RSTAT(1), a.in[I_LN2G], a.in[I_LN2B], 0.5f); } PHASE_END(PH_WOUT + 2)
    PHASE_BEGIN(PH_WOUT + 3) {
        P_(bf16_t, YB3, WS_B); P_(bf16_t, Wpg_t, WS_WPG); P_(bf16_t, PROJ, WS_XB);
        { pg8::Gemm g{YB3, Wpg_t, M, D, D}; pg8::StaticOrder S; S.init(M, D, c.G, c.bx);
          EpiGate E{a.out, PROJ, a.in[I_PBIAS], RSTAT(2), (const float*)(ws + WS_C1PG), (const float*)(ws + WS_C2PG), a.in[I_LN3G], a.in[I_LN3B]};
          pg8::gemm_phase<EpiGate, pg8::StaticOrder, PG_ALIGN, true>(c.lds, g, S, E, c.tid); }
    } PHASE_END(PH_WOUT + 3)
}

#ifndef MK_SPLIT
#define MK_SPLIT 0
#endif
extern "C" void kernel_launch(void* const* d_in, const int* in_sizes, int n_in, void* d_out, int out_size, void* d_ws, size_t ws_size, hipStream_t stream) {
    static int ready = 0;
    if (!ready) {
        if (n_in != 30 || out_size != M * D || ws_size < WS_END) { fprintf(stderr, "kernel_launch: unexpected problem (n_in %d out %d ws %zu)\n", n_in, out_size, ws_size); ready = -1; return; }
        if (hipFuncSetAttribute((const void*)mk_fwd, hipFuncAttributeMaxDynamicSharedMemorySize, LDS_BYTES) != hipSuccess) { fprintf(stderr, "kernel_launch: hipFuncSetAttribute failed\n"); ready = -1; return; }
        int per_cu = 0; (void)hipOccupancyMaxActiveBlocksPerMultiprocessor(&per_cu, (const void*)mk_fwd, 512, LDS_BYTES); (void)hipGetLastError();
        ready = 1;
    }
    if (ready < 0) return;
    if (hipMemsetAsync(d_ws, 0, 16384, stream) != hipSuccess) { fprintf(stderr, "kernel_launch: memset failed\n"); return; }
    Args a{};
    for (int i = 0; i < 30; ++i) a.in[i] = (const float*)d_in[i];
    a.out = (float*)d_out; a.ws = (unsigned char*)d_ws;
#if MK_SPLIT
    for (int ph = 0; ph < NPH; ++ph) { a.ph_lo = ph; a.ph_hi = ph + 1; hipLaunchKernelGGL(mk_fwd, dim3(256), dim3(512), LDS_BYTES, stream, a); }
#else
    a.ph_lo = 0; a.ph_hi = NPH;
    void* args[] = {&a};
    hipError_t e = hipLaunchCooperativeKernel((const void*)mk_fwd, dim3(256), dim3(512), args, LDS_BYTES, stream);
    if (e != hipSuccess) fprintf(stderr, "kernel_launch: cooperative launch failed: %s\n", hipGetErrorString(e));
#endif
}
```

```cpp
#include <hip/hip_runtime.h>
#include <hip/hip_cooperative_groups.h>
#include <cstdio>
#include <cstdint>
namespace cg = cooperative_groups;
namespace pg8 {
#define PG8_LAS __attribute__((address_space(3)))
typedef unsigned short bf16_t;
typedef short bf16x8 __attribute__((ext_vector_type(8)));
typedef float f32x4 __attribute__((ext_vector_type(4)));
typedef unsigned u32x4 __attribute__((ext_vector_type(4)));
constexpr int BM = 256, BK = 64, HALF = 128, HTB = HALF * BK * 2  , STAGE_BYTES = 8 * HTB, NXCD = 8, WGM = 4;

__host__ __device__ __forceinline__ int lds_byte(int r, int c) { const int st = (r >> 4) * 2 + (c >> 5), rr = r & 15, cc = c & 31, ob = rr * 64 + cc * 2; return st * 1024 + (ob ^ (((ob >> 9) & 1) << 5)); }
__host__ __device__ __forceinline__ void stage_rc(int b, int& R, int& C) { const int st = b / 1024, sb = b % 1024, swz = sb ^ (((sb >> 9) & 1) << 5); R = (st >> 1) * 16 + swz / 64; C = (st & 1) * 32 + (swz % 64) / 2; }
__host__ __device__ __forceinline__ int perm32(int rho) { const int n = rho >> 4, i = rho & 15; return 8 * (i >> 2) + 4 * n + (i & 3); }

struct Unit { int pm, pn; };
struct Gemm { const bf16_t* A; const bf16_t* Bt; int M, N, K; };

struct StaticOrder {
    int nM, nN, nwg, G, c;
    __host__ __device__ void init(int M, int N, int G_, int c_) { nM = M / BM; nN = N / BM; nwg = nM * nN; G = G_; c = c_; }
    __host__ __device__ bool next(int i, Unit& u) const {
        const long L = (long)i * G + c; if (L >= nwg) return false;
        int wgid = (int)L; { const int q = nwg / NXCD, r = nwg % NXCD, xcd = wgid % NXCD, off = wgid / NXCD; wgid = (xcd < r ? xcd * (q + 1) : r * (q + 1) + (xcd - r) * q) + off; }
        const int nig = WGM * nN, gid = wgid / nig, fm = gid * WGM, gsz = (nM - fm) < WGM ? (nM - fm) : WGM;
        u.pm = fm + ((wgid % nig) % gsz); u.pn = (wgid % nig) / gsz; return true;
    }
    __device__ __forceinline__ void a_ready(const Unit&) const {}
    __device__ __forceinline__ void done(const Unit&) const {}
};

__device__ __forceinline__ unsigned cvt_pk_bf16(float lo, float hi) { unsigned r; asm volatile("v_cvt_pk_bf16_f32 %0, %1, %2" : "=v"(r) : "v"(lo), "v"(hi)); return r; }
typedef float f32x2 __attribute__((ext_vector_type(2)));
template <class Epi, class Sched, bool ALIGN_EPI = false, bool SP2 = false>
__device__ __forceinline__ void gemm_phase(PG8_LAS unsigned char* lds, const Gemm g, const Sched& S, const Epi& E, const int tid) {
    const int wid = __builtin_amdgcn_readfirstlane(tid >> 6), lane = tid & 63, wr = wid >> 2, wc = wid & 3, fr = lane & 15, fq = lane >> 4;
    const int K = g.K, nt = K / BK;
    unsigned voffA[2], voffB[2];
#pragma unroll
    for (int i = 0; i < 2; ++i) { int R, C; stage_rc(tid * 16 + i * 8192, R, C); const int Rb = Epi::PERM ? ((R & ~31) + perm32(R & 31)) : R;
        voffA[i] = (unsigned)(R * K + C) * 2u; voffB[i] = (unsigned)(Rb * K + C) * 2u; }
    const size_t kstep = (size_t)(BK * 2);
    const size_t hstep = (size_t)HALF * K * 2;
    const size_t tstep = 2 * hstep;
    const unsigned ldsw = (unsigned)wid * 1024u;
    const int aoff = lds_byte(wr * 64 + fr, fq * 8), boff = lds_byte(wc * 32 + fr, fq * 8);
#define PG8_SA(b, h) (((b) * 2 + (h)) * HTB)
#define PG8_SB(b, h) ((4 + (b) * 2 + (h)) * HTB)
#define PG8_STAGE(bufoff, gbase, voff) do { _Pragma("unroll") for (int _i = 0; _i < 2; ++_i) \
        __builtin_amdgcn_global_load_lds((const unsigned*)((const char*)(gbase) + (voff)[_i]), (PG8_LAS unsigned*)(lds + (bufoff) + ldsw + _i * 8192), 16, 0, 0); } while (0)
#define PG8_LDA(dst, b, h) do { _Pragma("unroll") for (int m = 0; m < 4; ++m) _Pragma("unroll") for (int k = 0; k < 2; ++k) dst[m][k] = *(const PG8_LAS bf16x8*)(lds + PG8_SA(b, h) + aoff + m * 2048 + k * 1024); } while (0)
#define PG8_LDB(dst, b, h) do { _Pragma("unroll") for (int n = 0; n < 2; ++n) _Pragma("unroll") for (int k = 0; k < 2; ++k) dst[n][k] = *(const PG8_LAS bf16x8*)(lds + PG8_SB(b, h) + boff + n * 2048 + k * 1024); } while (0)
#define PG8_MMA(ai, bj, At, Bt) do { __builtin_amdgcn_s_setprio(1); _Pragma("unroll") for (int m = 0; m < 4; ++m) _Pragma("unroll") for (int n = 0; n < 2; ++n) _Pragma("unroll") for (int k = 0; k < 2; ++k) \
        acc[ai][bj][m][n] = __builtin_amdgcn_mfma_f32_16x16x32_bf16(Bt[n][k], At[m][k], acc[ai][bj][m][n], 0, 0, 0); __builtin_amdgcn_s_setprio(0); } while (0)
#define PG8_WAIT_V(n) asm volatile("s_waitcnt vmcnt(" #n ")" ::: "memory")
#define PG8_WAIT_L(n) asm volatile("s_waitcnt lgkmcnt(" #n ")" ::: "memory")
#define PG8_BAR __builtin_amdgcn_s_barrier()
#define PG8_SCHED __builtin_amdgcn_sched_barrier(0)
    Unit cur, nxt; int ui = 0;
    if (!S.next(0, cur)) return;
    f32x4 acc[2][2][4][2];
#pragma unroll
    for (int a = 0; a < 2; ++a)
#pragma unroll
        for (int b = 0; b < 2; ++b)
#pragma unroll
            for (int m = 0; m < 4; ++m)
#pragma unroll
                for (int n = 0; n < 2; ++n) acc[a][b][m][n] = (f32x4){0.f, 0.f, 0.f, 0.f};
    bf16x8 At[4][2], B0[2][2], B1[2][2];
    const char* cA = (const char*)g.A + (size_t)cur.pm * tstep; const char* cB = (const char*)g.Bt + (size_t)cur.pn * tstep;
    S.a_ready(cur);
    if constexpr (SP2) {
        PG8_STAGE(PG8_SB(0, 0), cB, voffB); PG8_STAGE(PG8_SB(0, 1), cB + hstep, voffB); PG8_STAGE(PG8_SA(0, 0), cA, voffA); PG8_STAGE(PG8_SA(0, 1), cA + hstep, voffA);
        if (wr == 1) PG8_BAR;
        PG8_WAIT_V(2); PG8_BAR;
        PG8_STAGE(PG8_SB(1, 0), cB + kstep, voffB); PG8_STAGE(PG8_SA(1, 0), cA + kstep, voffA); PG8_STAGE(PG8_SB(1, 1), cB + hstep + kstep, voffB);
        PG8_WAIT_V(6); PG8_BAR;
    } else {
        PG8_STAGE(PG8_SB(0, 0), cB, voffB); PG8_STAGE(PG8_SA(0, 0), cA, voffA); PG8_STAGE(PG8_SB(0, 1), cB + hstep, voffB); PG8_STAGE(PG8_SA(0, 1), cA + hstep, voffA);
        if (wr == 1) PG8_BAR;
        PG8_WAIT_V(4); PG8_BAR;
        PG8_STAGE(PG8_SB(1, 0), cB + kstep, voffB); PG8_STAGE(PG8_SA(1, 0), cA + kstep, voffA); PG8_STAGE(PG8_SB(1, 1), cB + hstep + kstep, voffB);
        PG8_WAIT_V(6); PG8_BAR;
    }
    for (;;) {
        const bool has_next = S.next(ui + 1, nxt);
        const char* nA = has_next ? (const char*)g.A + (size_t)nxt.pm * tstep : cA; const char* nB = has_next ? (const char*)g.Bt + (size_t)nxt.pn * tstep : cB;
        for (int t = 0; t < nt; t += 2) {
            const bool last = (t == nt - 2);
            const char* a1 = cA + (size_t)(t + 1) * kstep;
            const char* a2 = last ? nA : cA + (size_t)(t + 2) * kstep; const char* b2 = last ? nB : cB + (size_t)(t + 2) * kstep;
            const char* a3 = a2 + kstep; const char* b3 = b2 + kstep;
            if (last && has_next) S.a_ready(nxt);
            if constexpr (SP2) {
            PG8_LDB(B0, 0, 0); PG8_LDB(B1, 0, 1); PG8_SCHED; PG8_LDA(At, 0, 0); PG8_STAGE(PG8_SA(1, 1), a1 + hstep, voffA);
            PG8_WAIT_V(8); PG8_WAIT_L(0); PG8_BAR; PG8_MMA(0, 0, At, B0); PG8_MMA(0, 1, At, B1); PG8_BAR; PG8_SCHED;
            PG8_LDA(At, 0, 1); PG8_STAGE(PG8_SB(0, 0), b2, voffB); PG8_STAGE(PG8_SB(0, 1), b2 + hstep, voffB); PG8_STAGE(PG8_SA(0, 0), a2, voffA);
            PG8_WAIT_V(8); PG8_WAIT_L(0); PG8_BAR; PG8_MMA(1, 0, At, B0); PG8_MMA(1, 1, At, B1); PG8_BAR; PG8_SCHED;
            PG8_LDB(B0, 1, 0); PG8_LDB(B1, 1, 1); PG8_SCHED; PG8_LDA(At, 1, 0); PG8_STAGE(PG8_SA(0, 1), a2 + hstep, voffA);
            PG8_WAIT_V(8); PG8_WAIT_L(0); PG8_BAR; PG8_MMA(0, 0, At, B0); PG8_MMA(0, 1, At, B1); PG8_BAR; PG8_SCHED;
            PG8_LDA(At, 1, 1); PG8_STAGE(PG8_SB(1, 0), b3, voffB); PG8_STAGE(PG8_SB(1, 1), b3 + hstep, voffB); PG8_STAGE(PG8_SA(1, 0), a3, voffA);
            PG8_WAIT_V(8); PG8_WAIT_L(0); PG8_BAR; PG8_MMA(1, 0, At, B0); PG8_MMA(1, 1, At, B1); PG8_BAR; PG8_SCHED;
            } else {
            PG8_LDB(B0, 0, 0); PG8_SCHED; PG8_LDA(At, 0, 0); PG8_STAGE(PG8_SA(1, 1), a1 + hstep, voffA);
            PG8_WAIT_L(8); PG8_BAR; PG8_WAIT_L(0); PG8_MMA(0, 0, At, B0); PG8_BAR; PG8_SCHED;
            PG8_LDB(B1, 0, 1); PG8_STAGE(PG8_SB(0, 0), b2, voffB);
            PG8_BAR; PG8_WAIT_L(0); PG8_MMA(0, 1, At, B1); PG8_BAR;
            PG8_LDA(At, 0, 1); PG8_STAGE(PG8_SA(0, 0), a2, voffA);
            PG8_BAR; PG8_WAIT_L(0); PG8_MMA(1, 0, At, B0); PG8_BAR; PG8_SCHED;
            PG8_STAGE(PG8_SB(0, 1), b2 + hstep, voffB);
            PG8_WAIT_V(6); PG8_BAR; PG8_MMA(1, 1, At, B1); PG8_BAR;
            PG8_LDB(B0, 1, 0); PG8_SCHED; PG8_LDA(At, 1, 0); PG8_STAGE(PG8_SA(0, 1), a2 + hstep, voffA);
            PG8_WAIT_L(8); PG8_BAR; PG8_WAIT_L(0); PG8_MMA(0, 0, At, B0); PG8_BAR; PG8_SCHED;
            PG8_LDB(B1, 1, 1); PG8_STAGE(PG8_SB(1, 0), b3, voffB);
            PG8_BAR; PG8_WAIT_L(0); PG8_MMA(0, 1, At, B1); PG8_BAR;
            PG8_LDA(At, 1, 1); PG8_STAGE(PG8_SA(1, 0), a3, voffA);
            PG8_BAR; PG8_WAIT_L(0); PG8_MMA(1, 0, At, B0); PG8_BAR; PG8_SCHED;
            PG8_STAGE(PG8_SB(1, 1), b3 + hstep, voffB);
            PG8_WAIT_V(6); PG8_BAR; PG8_MMA(1, 1, At, B1); PG8_BAR;
            }
        }
        if constexpr (ALIGN_EPI) { if (wr == 0) PG8_BAR; }
        if constexpr (!Epi::AFTER_DRAIN) { E(acc, cur, wr, wc, fr, fq); S.done(cur); }
        if (!has_next) break;
#pragma unroll
        for (int a = 0; a < 2; ++a)
#pragma unroll
            for (int b = 0; b < 2; ++b)
#pragma unroll
                for (int m = 0; m < 4; ++m)
#pragma unroll
                    for (int n = 0; n < 2; ++n) acc[a][b][m][n] = (f32x4){0.f, 0.f, 0.f, 0.f};
        cur = nxt; cA = nA; cB = nB; ++ui;
        if constexpr (ALIGN_EPI) { if (wr == 1) PG8_BAR; }
    }
    PG8_WAIT_V(0);
    if constexpr (!ALIGN_EPI) { if (wr == 0) PG8_BAR; }
    PG8_BAR;
    if constexpr (Epi::AFTER_DRAIN) { E.fused(acc, cur, wr, wc, fr, fq, lds, wid, lane); S.done(cur); }
#undef PG8_SA
#undef PG8_SB
#undef PG8_STAGE
#undef PG8_LDA
#undef PG8_LDB
#undef PG8_MMA
#undef PG8_WAIT_V
#undef PG8_WAIT_L
#undef PG8_BAR
#undef PG8_SCHED
}
}

#define DI __device__ __forceinline__
#define LAS __attribute__((address_space(3)))
using pg8::bf16_t; using pg8::f32x4; using pg8::u32x4; using pg8::Unit; using pg8::cvt_pk_bf16;
typedef unsigned u32x2 __attribute__((ext_vector_type(2)));
typedef float f32x2v __attribute__((ext_vector_type(2)));

constexpr int M = 16384, D = 1024, SEQ = 4096, FF = 2816, NGU = 5632, NIN = 3872, NINP = 4096, KL = 384, NL = 1536, DP = 256;
constexpr int TR = 512, NR = SEQ / TR, REC = 384;
constexpr float ALPHA = 1.189207115002721f;
constexpr size_t MiB = (size_t)1 << 20;
constexpr size_t WS_ST = MiB / 2, WS_CS = 1 * MiB, WS_WGU = 2 * MiB, WS_WD = 13 * MiB, WS_WIN = 19 * MiB, WS_WLORA = 27 * MiB, WS_WOUT = 29 * MiB,
                 WS_WPG = 31 * MiB, WS_WPP = 33 * MiB, WS_PB = 34 * MiB, WS_XB = 42 * MiB, WS_A = 74 * MiB, WS_B = 162 * MiB, WS_SC = 226 * MiB, WS_END = 254 * MiB;
constexpr int LDS_BYTES = 136 * 1024;
constexpr size_t WS_C1WIN = 16384, WS_C2WIN = WS_C1WIN + 16384, WS_C1GU = WS_C2WIN + 16384, WS_C2GU = WS_C1GU + 24576, WS_C1PG = WS_C2GU + 24576, WS_C2PG = WS_C1PG + 4096, WS_RSTAT = 131072, WS_ZERO_BYTES = 524288;
constexpr float LN_EPS = 1e-5f;
#ifndef PG_ALIGN
#define PG_ALIGN true
#endif
#ifndef DUP_GEMM
#define DUP_GEMM 1
#endif
#ifndef DUP_RET
#define DUP_RET 1
#endif
#ifndef DUP_MISC
#define DUP_MISC 1
#endif

constexpr int NPH = 12 + (NR + 2);

DI int launder_v(int x) { asm volatile("" : "+v"(x)); return x; }
DI float bf2f(bf16_t v) { return __uint_as_float((unsigned)v << 16); }
DI bf16_t f2bf(float x) { return (bf16_t)(cvt_pk_bf16(x, 0.f) & 0xffffu); }
template <int CTRL> DI float dpp_f(float x) { return __builtin_bit_cast(float, __builtin_amdgcn_update_dpp(0, __builtin_bit_cast(int, x), CTRL, 0xf, 0xf, true)); }
DI float red16(float x) { x += dpp_f<0xB1>(x); x += dpp_f<0x4E>(x); x += dpp_f<0x141>(x); x += dpp_f<0x140>(x); return x; }
DI float sum_rows4(float x) {
    float a = x, b = x; asm("s_nop 1\n\tv_permlane16_swap_b32 %0, %1\n\ts_nop 1" : "+v"(a), "+v"(b)); x = a + b;
    a = x; b = x; asm("s_nop 1\n\tv_permlane32_swap_b32 %0, %1\n\ts_nop 1" : "+v"(a), "+v"(b)); return a + b;
}
DI float wave_sum(float v) { return sum_rows4(red16(v)); }
DI float sigmoidf_(float x) { return 1.0f / (1.0f + __expf(-x)); }
DI float silu_fast(float x) { return x * __builtin_amdgcn_rcpf(1.0f + __expf(-x)); }

DI void row_stats(const float* stat, int row, float& mu, float& rstd) {
    const f32x2v st = *(const f32x2v*)(stat + 2 * (size_t)row); mu = st.x * (1.0f / D); const float var = fmaxf(st.y * (1.0f / D) - mu * mu, 0.f); rstd = 1.0f / sqrtf(var + LN_EPS);
}
DI f32x4 ln_fix(f32x4 a, float mu, float rstd, f32x4 c1, f32x4 c2) { return (a - c1 * mu) * rstd + c2; }
struct EpiGU {
    static constexpr bool PERM = true, AFTER_DRAIN = false; bf16_t* H; const float* stat; const float* c1; const float* c2;
    DI void operator()(const f32x4 (&acc)[2][2][4][2], const Unit& u, int wr, int wc, int fr, int fq) const {
        const int row0 = u.pm * 256 + wr * 64 + fr, col0 = u.pn * 128 + wc * 32 + 8 * fq;
        f32x4 cc1[4], cc2[4];
        if (stat) { const int pc = u.pn * 256 + wc * 32 + 8 * fq;
            cc1[0] = *(const f32x4*)(c1 + pc); cc1[1] = *(const f32x4*)(c1 + pc + 4); cc1[2] = *(const f32x4*)(c1 + pc + 128); cc1[3] = *(const f32x4*)(c1 + pc + 132);
            cc2[0] = *(const f32x4*)(c2 + pc); cc2[1] = *(const f32x4*)(c2 + pc + 4); cc2[2] = *(const f32x4*)(c2 + pc + 128); cc2[3] = *(const f32x4*)(c2 + pc + 132); }
#pragma unroll
        for (int ai = 0; ai < 2; ++ai)
#pragma unroll
            for (int m = 0; m < 4; ++m) {
                bf16_t* p = H + (size_t)(row0 + ai * 128 + m * 16) * FF + col0;
                f32x4 g0 = acc[ai][0][m][0], g1 = acc[ai][0][m][1], u0 = acc[ai][1][m][0], u1 = acc[ai][1][m][1];
                if (stat) { float mu, rstd; row_stats(stat, row0 + ai * 128 + m * 16, mu, rstd);
                    g0 = ln_fix(g0, mu, rstd, cc1[0], cc2[0]); g1 = ln_fix(g1, mu, rstd, cc1[1], cc2[1]); u0 = ln_fix(u0, mu, rstd, cc1[2], cc2[2]); u1 = ln_fix(u1, mu, rstd, cc1[3], cc2[3]); }
                u32x4 w;
                w.x = cvt_pk_bf16(silu_fast(g0[0]) * u0[0], silu_fast(g0[1]) * u0[1]); w.y = cvt_pk_bf16(silu_fast(g0[2]) * u0[2], silu_fast(g0[3]) * u0[3]);
                w.z = cvt_pk_bf16(silu_fast(g1[0]) * u1[0], silu_fast(g1[1]) * u1[1]); w.w = cvt_pk_bf16(silu_fast(g1[2]) * u1[2], silu_fast(g1[3]) * u1[3]);
                *(u32x4*)p = w;
            }
    }
};
struct EpiRes {
    static constexpr bool PERM = true, AFTER_DRAIN = false; const float* Xraw; float* Yio; bf16_t* YB; float* stat_out; const float* ln_stat; const float* ln_g; const float* ln_b; float s;
    DI void operator()(const f32x4 (&acc)[2][2][4][2], const Unit& u, int wr, int wc, int fr, int fq) const {
        const int row0 = u.pm * 256 + wr * 64 + fr, col0 = u.pn * 256 + wc * 32 + 8 * fq;
        f32x4 gv[2][2], bv[2][2];
        if (ln_stat) {
#pragma unroll
            for (int bj = 0; bj < 2; ++bj) { gv[bj][0] = *(const f32x4*)(ln_g + col0 + bj * 128); gv[bj][1] = *(const f32x4*)(ln_g + col0 + bj * 128 + 4); bv[bj][0] = *(const f32x4*)(ln_b + col0 + bj * 128); bv[bj][1] = *(const f32x4*)(ln_b + col0 + bj * 128 + 4); }
        }
#pragma unroll
        for (int ai = 0; ai < 2; ++ai)
#pragma unroll
            for (int m = 0; m < 4; ++m) {
                const int row = row0 + ai * 128 + m * 16; float mu = 0.f, rstd = 1.f; if (ln_stat) row_stats(ln_stat, row, mu, rstd);
                float rs = 0.f, rq = 0.f;
#pragma unroll
                for (int bj = 0; bj < 2; ++bj) {
                    const size_t off = (size_t)row * D + col0 + bj * 128;
                    f32x4 x0, x1;
                    if (ln_stat) { x0 = *(const f32x4*)(Yio + off); x1 = *(const f32x4*)(Yio + off + 4);
                        x0 = (x0 - mu) * rstd * gv[bj][0] + bv[bj][0]; x1 = (x1 - mu) * rstd * gv[bj][1] + bv[bj][1]; }
                    else { x0 = *(const f32x4*)(Xraw + off); x1 = *(const f32x4*)(Xraw + off + 4); }
                    const f32x4 y0 = x0 * ALPHA + acc[ai][bj][m][0] * s, y1 = x1 * ALPHA + acc[ai][bj][m][1] * s;
                    *(f32x4*)(Yio + off) = y0; *(f32x4*)(Yio + off + 4) = y1;
                    u32x4 w; w.x = cvt_pk_bf16(y0[0], y0[1]); w.y = cvt_pk_bf16(y0[2], y0[3]); w.z = cvt_pk_bf16(y1[0], y1[1]); w.w = cvt_pk_bf16(y1[2], y1[3]);
                    *(u32x4*)(YB + off) = w;
                    rs += (y0[0] + y0[1]) + (y0[2] + y0[3]) + (y1[0] + y1[1]) + (y1[2] + y1[3]);
                    rq += (y0[0] * y0[0] + y0[1] * y0[1]) + (y0[2] * y0[2] + y0[3] * y0[3]) + (y1[0] * y1[0] + y1[1] * y1[1]) + (y1[2] * y1[2] + y1[3] * y1[3]);
                }
                rs = sum_rows4(rs); rq = sum_rows4(rq);
                if (fq == 0) { atomicAdd(stat_out + 2 * (size_t)row, rs); atomicAdd(stat_out + 2 * (size_t)row + 1, rq); }
            }
    }
};
struct EpiWin {
    static constexpr bool PERM = true, AFTER_DRAIN = false; bf16_t* ZRET; bf16_t* ZRW; const float* CS; const float* stat; const float* c1; const float* c2;
    DI void operator()(const f32x4 (&acc)[2][2][4][2], const Unit& u, int wr, int wc, int fr, int fq) const {
        const int row0 = u.pm * 256 + wr * 64 + fr;
        f32x4 cc1[4], cc2[4];
        { const int pc = u.pn * 256 + wc * 32 + 8 * fq;
            cc1[0] = *(const f32x4*)(c1 + pc); cc1[1] = *(const f32x4*)(c1 + pc + 4); cc1[2] = *(const f32x4*)(c1 + pc + 128); cc1[3] = *(const f32x4*)(c1 + pc + 132);
            cc2[0] = *(const f32x4*)(c2 + pc); cc2[1] = *(const f32x4*)(c2 + pc + 4); cc2[2] = *(const f32x4*)(c2 + pc + 128); cc2[3] = *(const f32x4*)(c2 + pc + 132); }
        if (u.pn < 4) {
            const int sec = u.pn >> 1, head = (u.pn & 1) * 4 + wc; const float sc = sec ? 0.125f : 1.0f;
#pragma unroll
            for (int ai = 0; ai < 2; ++ai)
#pragma unroll
                for (int m = 0; m < 4; ++m) {
                    const int row = row0 + ai * 128 + m * 16, pos = row & (SEQ - 1);
                    const f32x4* cs = (const f32x4*)(CS + ((size_t)pos * 32 + 8 * fq) * 2);
                    const f32x4 c01 = cs[0], c23 = cs[1], c45 = cs[2], c67 = cs[3];
                    float mu, rstd; row_stats(stat, row, mu, rstd);
                    const f32x4 a0 = ln_fix(acc[ai][0][m][0], mu, rstd, cc1[0], cc2[0]), a1 = ln_fix(acc[ai][0][m][1], mu, rstd, cc1[1], cc2[1]),
                                b0 = ln_fix(acc[ai][1][m][0], mu, rstd, cc1[2], cc2[2]), b1 = ln_fix(acc[ai][1][m][1], mu, rstd, cc1[3], cc2[3]);
                    u32x4 o1, o2;
                    o1.x = cvt_pk_bf16((a0[0] * c01[0] - b0[0] * c01[1]) * sc, (a0[1] * c01[2] - b0[1] * c01[3]) * sc);
                    o1.y = cvt_pk_bf16((a0[2] * c23[0] - b0[2] * c23[1]) * sc, (a0[3] * c23[2] - b0[3] * c23[3]) * sc);
                    o1.z = cvt_pk_bf16((a1[0] * c45[0] - b1[0] * c45[1]) * sc, (a1[1] * c45[2] - b1[1] * c45[3]) * sc);
                    o1.w = cvt_pk_bf16((a1[2] * c67[0] - b1[2] * c67[1]) * sc, (a1[3] * c67[2] - b1[3] * c67[3]) * sc);
                    o2.x = cvt_pk_bf16((a0[0] * c01[1] + b0[0] * c01[0]) * sc, (a0[1] * c01[3] + b0[1] * c01[2]) * sc);
                    o2.y = cvt_pk_bf16((a0[2] * c23[1] + b0[2] * c23[0]) * sc, (a0[3] * c23[3] + b0[3] * c23[2]) * sc);
                    o2.z = cvt_pk_bf16((a1[0] * c45[1] + b1[0] * c45[0]) * sc, (a1[1] * c45[3] + b1[1] * c45[2]) * sc);
                    o2.w = cvt_pk_bf16((a1[2] * c67[1] + b1[2] * c67[0]) * sc, (a1[3] * c67[3] + b1[3] * c67[2]) * sc);
                    bf16_t* p = ZRET + (size_t)row * 2048 + sec * 512 + head * 64 + 8 * fq;
                    *(u32x4*)p = o1; *(u32x4*)(p + 32) = o2;
                }
        } else {
            bf16_t* base = (u.pn < 8) ? ZRET + u.pn * 256 : ZRW + (u.pn - 8) * 256;
            const int col0 = wc * 32 + 8 * fq;
#pragma unroll
            for (int ai = 0; ai < 2; ++ai)
#pragma unroll
                for (int m = 0; m < 4; ++m)
#pragma unroll
                    for (int bj = 0; bj < 2; ++bj) {
                        float mu, rstd; row_stats(stat, row0 + ai * 128 + m * 16, mu, rstd);
                        const f32x4 v0 = ln_fix(acc[ai][bj][m][0], mu, rstd, cc1[2 * bj], cc2[2 * bj]), v1 = ln_fix(acc[ai][bj][m][1], mu, rstd, cc1[2 * bj + 1], cc2[2 * bj + 1]); u32x4 w;
                        w.x = cvt_pk_bf16(v0[0], v0[1]); w.y = cvt_pk_bf16(v0[2], v0[3]); w.z = cvt_pk_bf16(v1[0], v1[1]); w.w = cvt_pk_bf16(v1[2], v1[3]);
                        *(u32x4*)(base + (size_t)(row0 + ai * 128 + m * 16) * 2048 + col0 + bj * 128) = w;
                    }
        }
    }
};
DI float decay_from_lora(float x) { const float nx = -x; const float sp = fmaxf(nx, 0.f) + log1pf(__expf(-fabsf(nx))); return __expf(-__expf(-sp - 0.5f)); }
struct EpiLora {
    static constexpr bool PERM = true, AFTER_DRAIN = false; float* LW; bf16_t* LA2; bf16_t* LG; const float* w0; const float* a0;
    DI void operator()(const f32x4 (&acc)[2][2][4][2], const Unit& u, int wr, int wc, int fr, int fq) const {
        const int row0 = u.pm * 256 + wr * 64 + fr, kind = u.pn >> 1, cb = (u.pn & 1) * 256 + wc * 32 + 8 * fq;
        if (kind == 0) {
#pragma unroll
            for (int bj = 0; bj < 2; ++bj) {
                const f32x4 bi0 = *(const f32x4*)(w0 + cb + bj * 128), bi1 = *(const f32x4*)(w0 + cb + bj * 128 + 4);
#pragma unroll
                for (int ai = 0; ai < 2; ++ai)
#pragma unroll
                    for (int m = 0; m < 4; ++m) {
                        const size_t off = (size_t)(row0 + ai * 128 + m * 16) * 512 + cb + bj * 128;
                        const f32x4 v0 = acc[ai][bj][m][0] + bi0, v1 = acc[ai][bj][m][1] + bi1; f32x4 o0, o1;
                        o0 = v0; o1 = v1;
                        *(f32x4*)(LW + off) = o0; *(f32x4*)(LW + off + 4) = o1;
                    }
            }
        } else if (kind == 1) {
#pragma unroll
            for (int bj = 0; bj < 2; ++bj) {
                const f32x4 bi0 = *(const f32x4*)(a0 + cb + bj * 128), bi1 = *(const f32x4*)(a0 + cb + bj * 128 + 4);
#pragma unroll
                for (int ai = 0; ai < 2; ++ai)
#pragma unroll
                    for (int m = 0; m < 4; ++m) {
                        const size_t off = (size_t)(row0 + ai * 128 + m * 16) * 512 + cb + bj * 128;
                        const f32x4 v0 = acc[ai][bj][m][0] + bi0, v1 = acc[ai][bj][m][1] + bi1; u32x4 w;
                        w.x = cvt_pk_bf16(v0[0], v0[1]); w.y = cvt_pk_bf16(v0[2], v0[3]); w.z = cvt_pk_bf16(v1[0], v1[1]); w.w = cvt_pk_bf16(v1[2], v1[3]);
                        *(u32x4*)(LA2 + off) = w;
                    }
            }
        } else {
#pragma unroll
            for (int bj = 0; bj < 2; ++bj)
#pragma unroll
                for (int ai = 0; ai < 2; ++ai)
#pragma unroll
                    for (int m = 0; m < 4; ++m) {
                        const size_t off = (size_t)(row0 + ai * 128 + m * 16) * 512 + cb + bj * 128;
                        const f32x4 v0 = acc[ai][bj][m][0], v1 = acc[ai][bj][m][1]; u32x4 w;
                        w.x = cvt_pk_bf16(v0[0], v0[1]); w.y = cvt_pk_bf16(v0[2], v0[3]); w.z = cvt_pk_bf16(v1[0], v1[1]); w.w = cvt_pk_bf16(v1[2], v1[3]);
                        *(u32x4*)(LG + off) = w;
                    }
        }
    }
};
struct EpiProj {
    static constexpr bool PERM = true, AFTER_DRAIN = false; bf16_t* P;
    DI void operator()(const f32x4 (&acc)[2][2][4][2], const Unit& u, int wr, int wc, int fr, int fq) const {
        const int row0 = u.pm * 256 + wr * 64 + fr, col0 = u.pn * 256 + wc * 32 + 8 * fq;
#pragma unroll
        for (int ai = 0; ai < 2; ++ai)
#pragma unroll
            for (int m = 0; m < 4; ++m)
#pragma unroll
                for (int bj = 0; bj < 2; ++bj) {
                    const size_t off = (size_t)(row0 + ai * 128 + m * 16) * D + col0 + bj * 128;
                    const f32x4 v0 = acc[ai][bj][m][0], v1 = acc[ai][bj][m][1]; u32x4 w;
                    w.x = cvt_pk_bf16(v0[0], v0[1]); w.y = cvt_pk_bf16(v0[2], v0[3]); w.z = cvt_pk_bf16(v1[0], v1[1]); w.w = cvt_pk_bf16(v1[2], v1[3]);
                    *(u32x4*)(P + off) = w;
                }
    }
};
struct EpiGate {
    static constexpr bool PERM = true, AFTER_DRAIN = false; float* XO; const bf16_t* P; const float* bias; const float* stat; const float* c1; const float* c2; const float* ln_g; const float* ln_b;
    DI void operator()(const f32x4 (&acc)[2][2][4][2], const Unit& u, int wr, int wc, int fr, int fq) const {
        const int row0 = u.pm * 256 + wr * 64 + fr, col0 = u.pn * 256 + wc * 32 + 8 * fq;
#pragma unroll
        for (int ai = 0; ai < 2; ++ai)
#pragma unroll
            for (int m = 0; m < 4; ++m) {
                const int row = row0 + ai * 128 + m * 16; float mu, rstd; row_stats(stat, row, mu, rstd);
#pragma unroll
                for (int bj = 0; bj < 2; ++bj) {
                    const int col = col0 + bj * 128; const size_t off = (size_t)row * D + col;
                    const f32x4 bb0 = *(const f32x4*)(bias + col), bb1 = *(const f32x4*)(bias + col + 4);
                    const f32x4 g0 = ln_fix(acc[ai][bj][m][0], mu, rstd, *(const f32x4*)(c1 + col), *(const f32x4*)(c2 + col)) + bb0, g1 = ln_fix(acc[ai][bj][m][1], mu, rstd, *(const f32x4*)(c1 + col + 4), *(const f32x4*)(c2 + col + 4)) + bb1;
                    f32x4 x0 = *(const f32x4*)(XO + off), x1 = *(const f32x4*)(XO + off + 4); const u32x4 pw = *(const u32x4*)(P + off);
                    const f32x4 p0 = (f32x4){__uint_as_float(pw.x << 16), __uint_as_float(pw.x & 0xffff0000u), __uint_as_float(pw.y << 16), __uint_as_float(pw.y & 0xffff0000u)},
                                p1 = (f32x4){__uint_as_float(pw.z << 16), __uint_as_float(pw.z & 0xffff0000u), __uint_as_float(pw.w << 16), __uint_as_float(pw.w & 0xffff0000u)};
                    x0 = (x0 - mu) * rstd * *(const f32x4*)(ln_g + col) + *(const f32x4*)(ln_b + col); x1 = (x1 - mu) * rstd * *(const f32x4*)(ln_g + col + 4) + *(const f32x4*)(ln_b + col + 4);
                    f32x4 o0, o1;
#pragma unroll
                    for (int e = 0; e < 4; ++e) { o0[e] = x0[e] + sigmoidf_(g0[e]) * p0[e]; o1[e] = x1[e] + sigmoidf_(g1[e]) * p1[e]; }
                    *(f32x4*)(XO + off) = o0; *(f32x4*)(XO + off + 4) = o1;
                }
            }
    }
};

struct Ctx { int tid, lane, wave, bx, G, gw, NGW, gtid, NGT; LAS unsigned char* lds; };

DI void transpose_item(const float* __restrict__ W, int N, bf16_t* __restrict__ WT, int K, int dst_row0, int k0, int n0, LAS float* scr, int lane,
                       const float* lng = nullptr, const float* lnb = nullptr, float* c1 = nullptr, float* c2 = nullptr) {
    const int kr = lane >> 3, nq = (lane & 7) * 4;
    f32x4 v[8];
#pragma unroll
    for (int i = 0; i < 8; ++i) v[i] = __builtin_nontemporal_load((const f32x4*)(W + (size_t)(k0 + kr + 8 * i) * N + n0 + nq));
    if (lng) {
        f32x4 cp = (f32x4){0.f, 0.f, 0.f, 0.f};
#pragma unroll
        for (int i = 0; i < 8; ++i) { cp = cp + v[i] * lnb[k0 + kr + 8 * i]; v[i] = v[i] * lng[k0 + kr + 8 * i]; }
#pragma unroll
        for (int j = 0; j < 4; ++j) { float t = cp[j]; t += __shfl_xor(t, 8); t += __shfl_xor(t, 16); t += __shfl_xor(t, 32); cp[j] = t; }
        if (lane < 8) {
#pragma unroll
            for (int j = 0; j < 4; ++j) atomicAdd(c2 + dst_row0 + nq + j, cp[j]);
        }
    }
#pragma unroll
    for (int i = 0; i < 8; ++i) { LAS float* d = scr + (kr + 8 * i) * 33 + nq; d[0] = v[i][0]; d[1] = v[i][1]; d[2] = v[i][2]; d[3] = v[i][3]; }
    asm volatile("s_waitcnt lgkmcnt(0)" ::: "memory");
    const int c = lane & 7;
#pragma unroll
    for (int j = 0; j < 4; ++j) { const int n = (lane >> 3) + 8 * j; const LAS float* s = scr + (8 * c) * 33 + n;
        u32x4 o; o.x = cvt_pk_bf16(s[0], s[33]); o.y = cvt_pk_bf16(s[66], s[99]); o.z = cvt_pk_bf16(s[132], s[165]); o.w = cvt_pk_bf16(s[198], s[231]);
        *(u32x4*)(WT + (size_t)(dst_row0 + n) * K + k0 + 8 * c) = o;
        if (lng) {
            float t = 0.f;
#pragma unroll
            for (int e = 0; e < 4; ++e) t += __uint_as_float(o[e] << 16) + __uint_as_float(o[e] & 0xffff0000u);
            t += __shfl_xor(t, 1); t += __shfl_xor(t, 2); t += __shfl_xor(t, 4);
            if (c == 0) atomicAdd(c1 + dst_row0 + n, t);
        } }
    asm volatile("s_waitcnt lgkmcnt(0)" ::: "memory");
}
DI int gu_dst_row(int c0) { const int isup = c0 >= FF; const int c = isup ? c0 - FF : c0; return 256 * (c >> 7) + 128 * isup + (c & 127); }
DI int win_dst_row(int c0) {
    if (c0 < 1024) { const int sec = c0 >> 9, hh = (c0 & 511) >> 6, half = (c0 & 63) >> 5; return 256 * (sec * 2 + (hh >> 2)) + 128 * half + 32 * (hh & 3); }
    return c0;
}
DI void cvt_rows_bf16(const Ctx& c, const float* src, bf16_t* dst, size_t n4) {
    for (size_t i = c.gtid; i < n4; i += c.NGT) { const f32x4 v = __builtin_nontemporal_load((const f32x4*)src + i); u32x2 o; o.x = cvt_pk_bf16(v[0], v[1]); o.y = cvt_pk_bf16(v[2], v[3]); ((u32x2*)dst)[i] = o; }
}
DI void convert_ffn(const Ctx& c, const float* wgu, const float* wd, bf16_t* Wgu_t, bf16_t* Wd_t, const float* lng = nullptr, const float* lnb = nullptr, float* c1 = nullptr, float* c2 = nullptr) {
    LAS float* scr = (LAS float*)(c.lds + c.wave * 8448);
    for (int it = c.gw; it < 2816 + 1408; it += c.NGW) {
        if (it < 2816) { const int kb = it / 176, nb = it % 176; transpose_item(wgu, NGU, Wgu_t, D, gu_dst_row(32 * nb), 64 * kb, 32 * nb, scr, c.lane, lng, lnb, c1, c2); }
        else { const int r = it - 2816, kb = r / 32, nb = r % 32; transpose_item(wd, D, Wd_t, FF, 32 * nb, 64 * kb, 32 * nb, scr, c.lane); }
    }
}
DI void layer_norm_rows(const Ctx& c, const float* Y, const float* g, const float* b, float* XF, bf16_t* XB) {
    const f32x4 g0 = ((const f32x4*)g)[c.lane], g1 = ((const f32x4*)g)[c.lane + 64], g2 = ((const f32x4*)g)[c.lane + 128], g3 = ((const f32x4*)g)[c.lane + 192];
    const f32x4 b0 = ((const f32x4*)b)[c.lane], b1 = ((const f32x4*)b)[c.lane + 64], b2 = ((const f32x4*)b)[c.lane + 128], b3 = ((const f32x4*)b)[c.lane + 192];
    for (int m = c.gw; m < M; m += c.NGW) {
        const f32x4* yr = (const f32x4*)(Y + (size_t)m * D) + c.lane;
        f32x4 v0 = yr[0], v1 = yr[64], v2 = yr[128], v3 = yr[192];
        float s = (v0[0] + v0[1] + v0[2] + v0[3]) + (v1[0] + v1[1] + v1[2] + v1[3]) + (v2[0] + v2[1] + v2[2] + v2[3]) + (v3[0] + v3[1] + v3[2] + v3[3]);
        const float mean = wave_sum(s) * (1.0f / D);
        v0 = v0 - mean; v1 = v1 - mean; v2 = v2 - mean; v3 = v3 - mean;
        float q = (v0[0] * v0[0] + v0[1] * v0[1] + v0[2] * v0[2] + v0[3] * v0[3]) + (v1[0] * v1[0] + v1[1] * v1[1] + v1[2] * v1[2] + v1[3] * v1[3])
                + (v2[0] * v2[0] + v2[1] * v2[1] + v2[2] * v2[2] + v2[3] * v2[3]) + (v3[0] * v3[0] + v3[1] * v3[1] + v3[2] * v3[2] + v3[3] * v3[3]);
        const float rstd = 1.0f / sqrtf(wave_sum(q) * (1.0f / D) + 1e-5f);
        v0 = v0 * rstd * g0 + b0; v1 = v1 * rstd * g1 + b1; v2 = v2 * rstd * g2 + b2; v3 = v3 * rstd * g3 + b3;
        f32x4* xo = (f32x4*)(XF + (size_t)m * D) + c.lane; xo[0] = v0; xo[64] = v1; xo[128] = v2; xo[192] = v3;
        u32x2* bo = (u32x2*)(XB + (size_t)m * D) + c.lane; u32x2 o;
        o.x = cvt_pk_bf16(v0[0], v0[1]); o.y = cvt_pk_bf16(v0[2], v0[3]); bo[0] = o;
        o.x = cvt_pk_bf16(v1[0], v1[1]); o.y = cvt_pk_bf16(v1[2], v1[3]); bo[64] = o;
        o.x = cvt_pk_bf16(v2[0], v2[1]); o.y = cvt_pk_bf16(v2[2], v2[3]); bo[128] = o;
        o.x = cvt_pk_bf16(v3[0], v3[1]); o.y = cvt_pk_bf16(v3[2], v3[3]); bo[192] = o;
    }
}
DI float zshift(const bf16_t* ZRW, size_t t, int tin, int col, const float* mu) {
    const float z = bf2f(ZRW[t * 2048 + col]); const float zp = tin ? bf2f(ZRW[(t - 1) * 2048 + col]) : 0.f;
    return z + (zp - z) * mu[col];
}
DI void prep_lora_a(const Ctx& c, const bf16_t* ZRW, const float* mu, bf16_t* LA) {
    for (int i = c.gtid; i < M * (KL / 8); i += c.NGT) {
        const int t = i / (KL / 8), g = i % (KL / 8); u32x4 o = (u32x4){0u, 0u, 0u, 0u};
        if (g < 36) {
            const int col = 1536 + 8 * g;
            const u32x4 zc = *(const u32x4*)(ZRW + (size_t)t * 2048 + col); u32x4 zp = (u32x4){0u, 0u, 0u, 0u};
            if (t & (SEQ - 1)) zp = *(const u32x4*)(ZRW + (size_t)(t - 1) * 2048 + col);
            const f32x4 m0 = *(const f32x4*)(mu + col), m1 = *(const f32x4*)(mu + col + 4);
            float r[8];
#pragma unroll
            for (int e = 0; e < 8; ++e) {
                const unsigned zw = zc[e >> 1], pw = zp[e >> 1];
                const float z = (e & 1) ? __uint_as_float(zw & 0xffff0000u) : __uint_as_float(zw << 16), pz = (e & 1) ? __uint_as_float(pw & 0xffff0000u) : __uint_as_float(pw << 16);
                const float m = e < 4 ? m0[e & 3] : m1[e & 3]; const float s = z + (pz - z) * m;
                r[e] = g < 8 ? 1.0f - 2.0f / (1.0f + __expf(2.0f * s)) : (g < 16 ? s : sigmoidf_(s));
            }
            o.x = cvt_pk_bf16(r[0], r[1]); o.y = cvt_pk_bf16(r[2], r[3]); o.z = cvt_pk_bf16(r[4], r[5]); o.w = cvt_pk_bf16(r[6], r[7]);
        }
        *(u32x4*)(LA + (size_t)t * KL + 8 * g) = o;
    }
}
DI float ret_lg2(int h) { return log1pf(-exp2f(-5.0f - (float)h)) * 1.4426950408889634f; }
DI void ret_kv(const Ctx& c, const bf16_t* ZRET, float* KV) {
    typedef pg8::bf16x8 bf16x8;
    const int w = c.wave, lane = c.lane, fr = lane & 15, fq = lane >> 4, dt = w >> 1, et0 = (w & 1) * 2;
    LAS unsigned char* L = c.lds;
    constexpr int OKT = 0, OVT = 17408;
    for (int u = c.bx; u < 1024; u += c.G) {
        const int bh = u >> 5, n = u & 31, b = bh >> 3, h = bh & 7; const float lg2 = ret_lg2(h);
        const bf16_t* zb = ZRET + ((size_t)b * SEQ + n * 128) * 2048 + h * 64;
#pragma unroll
        for (int x = 0; x < 2; ++x) {
            const int g = c.tid + 512 * x, j = g >> 3, dg = (g & 7) * 8; const bf16_t* p = zb + (size_t)j * 2048 + dg;
            const u32x4 rk = *(const u32x4*)(p + 512), rv = *(const u32x4*)(p + 1024);
            const float dj = exp2f((float)(127 - j) * lg2);
#pragma unroll
            for (int i = 0; i < 8; ++i) {
                const unsigned kw = (rk[i >> 1] >> (16 * (i & 1))) & 0xffffu, vw = (rv[i >> 1] >> (16 * (i & 1))) & 0xffffu;
                *(LAS bf16_t*)(L + OKT + (dg + i) * 272 + j * 2) = f2bf(bf2f((bf16_t)kw) * dj);
                *(LAS bf16_t*)(L + OVT + (dg + i) * 272 + j * 2) = (bf16_t)vw;
            }
        }
        __syncthreads();
        f32x4 sacc[2]; sacc[0] = (f32x4){0.f, 0.f, 0.f, 0.f}; sacc[1] = sacc[0];
#pragma unroll
        for (int ks = 0; ks < 4; ++ks) { const bf16x8 ka = *(const LAS bf16x8*)(L + OKT + (16 * dt + fr) * 272 + (ks * 32 + fq * 8) * 2);
#pragma unroll
            for (int x = 0; x < 2; ++x) { const bf16x8 vb = *(const LAS bf16x8*)(L + OVT + (16 * (et0 + x) + fr) * 272 + (ks * 32 + fq * 8) * 2); sacc[x] = __builtin_amdgcn_mfma_f32_16x16x32_bf16(ka, vb, sacc[x], 0, 0, 0); } }
        float* kvo = KV + (size_t)u * 4096;
#pragma unroll
        for (int x = 0; x < 2; ++x) *(f32x4*)(kvo + (16 * (et0 + x) + fr) * 64 + 16 * dt + fq * 4) = sacc[x];
        __syncthreads();
    }
}
DI void ret_prefix(const Ctx& c, const float* KV, bf16_t* PS) {
    for (int idx = c.gtid; idx < 32 * 4096; idx += c.NGT) {
        const int bh = idx >> 12, e = (idx >> 6) & 63, d = idx & 63; const float cdec = exp2f(128.0f * ret_lg2(bh & 7));
        float st = 0.f;
        float kv[8];
        for (int n0 = 0; n0 < 32; n0 += 8) {
#pragma unroll
            for (int j = 0; j < 8; ++j) kv[j] = KV[(size_t)(bh * 32 + n0 + j) * 4096 + e * 64 + d];
#pragma unroll
            for (int j = 0; j < 8; ++j) { PS[(size_t)(bh * 32 + n0 + j) * 4096 + e * 64 + d] = f2bf(st); st = st * cdec + kv[j]; }
        }
    }
}
DI void ret_out(const Ctx& c, const bf16_t* ZRET, const bf16_t* PS, const float* gn_g, const float* gn_b, bf16_t* MIX) {
    typedef pg8::bf16x8 bf16x8;
    const int w = c.wave, lane = c.lane, fr = lane & 15, fq = lane >> 4, i0 = 16 * w;
    LAS unsigned char* L = c.lds;
    constexpr int OQ = 0, OKS = 18432, OVT = 36864, OP = 54272;
    LAS unsigned char* Pw = L + OP + w * 4352;
    u32x4 rq[2], rk[2], rv[2], rg[2];
    constexpr int OG = 89088;
#define RET_LOAD(u_) do { const int bh_ = (u_) >> 5, n_ = (u_) & 31; const bf16_t* zb_ = ZRET + ((size_t)(bh_ >> 3) * SEQ + n_ * 128) * 2048 + (bh_ & 7) * 64; \
        _Pragma("unroll") for (int x = 0; x < 2; ++x) { const int g = c.tid + 512 * x, j = g >> 3, dg = (g & 7) * 8; const bf16_t* p = zb_ + (size_t)j * 2048 + dg; \
        rq[x] = *(const u32x4*)p; rk[x] = *(const u32x4*)(p + 512); rv[x] = *(const u32x4*)(p + 1024); rg[x] = *(const u32x4*)(p + 1536); } } while (0)
    if (c.bx < 1024) RET_LOAD(c.bx);
    for (int u = c.bx; u < 1024; u += c.G) {
        const int bh = u >> 5, n = u & 31, b = bh >> 3, h = bh & 7; const float lg2 = ret_lg2(h);
#pragma unroll
        for (int x = 0; x < 2; ++x) {
            const int g = c.tid + 512 * x, j = g >> 3, dg = (g & 7) * 8;
            *(LAS u32x4*)(L + OQ + j * 144 + dg * 2) = rq[x]; *(LAS u32x4*)(L + OKS + j * 144 + dg * 2) = rk[x]; *(LAS u32x4*)(L + OG + j * 144 + dg * 2) = rg[x];
#pragma unroll
            for (int i = 0; i < 8; ++i) *(LAS bf16_t*)(L + OVT + (dg + i) * 272 + j * 2) = (bf16_t)((rv[x][i >> 1] >> (16 * (i & 1))) & 0xffffu);
        }
        if (u + c.G < 1024) RET_LOAD(u + c.G);
        const size_t t0 = (size_t)b * SEQ + n * 128 + i0 + fq * 4;
        bf16x8 sb[2][4];
#pragma unroll
        for (int ks = 0; ks < 2; ++ks)
#pragma unroll
            for (int et = 0; et < 4; ++et) sb[ks][et] = *(const bf16x8*)(PS + (size_t)u * 4096 + (16 * et + fr) * 64 + ks * 32 + fq * 8);
        float gg[4], gb[4];
#pragma unroll
        for (int et = 0; et < 4; ++et) { gg[et] = gn_g[h * 64 + 16 * et + fr]; gb[et] = gn_b[h * 64 + 16 * et + fr]; }
        __syncthreads();
        bf16x8 qa[2];
#pragma unroll
        for (int ks = 0; ks < 2; ++ks) qa[ks] = *(const LAS bf16x8*)(L + OQ + (i0 + fr) * 144 + (ks * 32 + fq * 8) * 2);
#pragma unroll
        for (int jt = 0; jt < 8; ++jt) {
            f32x4 sc = (f32x4){0.f, 0.f, 0.f, 0.f};
#pragma unroll
            for (int ks = 0; ks < 2; ++ks) { const bf16x8 kb = *(const LAS bf16x8*)(L + OKS + (16 * jt + fr) * 144 + (ks * 32 + fq * 8) * 2); sc = __builtin_amdgcn_mfma_f32_16x16x32_bf16(qa[ks], kb, sc, 0, 0, 0); }
#pragma unroll
            for (int r = 0; r < 4; ++r) { const int di = (i0 + fq * 4 + r) - (16 * jt + fr); const float pv = di >= 0 ? sc[r] * exp2f((float)di * lg2) : 0.f;
                *(LAS bf16_t*)(Pw + (fq * 4 + r) * 272 + (16 * jt + fr) * 2) = f2bf(pv); }
        }
        f32x4 o[4], cr[4];
#pragma unroll
        for (int et = 0; et < 4; ++et) { o[et] = (f32x4){0.f, 0.f, 0.f, 0.f}; cr[et] = o[et]; }
#pragma unroll
        for (int ks = 0; ks < 4; ++ks) { const bf16x8 pa = *(const LAS bf16x8*)(Pw + fr * 272 + (ks * 32 + fq * 8) * 2);
#pragma unroll
            for (int et = 0; et < 4; ++et) { const bf16x8 vb = *(const LAS bf16x8*)(L + OVT + (16 * et + fr) * 272 + (ks * 32 + fq * 8) * 2); o[et] = __builtin_amdgcn_mfma_f32_16x16x32_bf16(pa, vb, o[et], 0, 0, 0); } }
#pragma unroll
        for (int ks = 0; ks < 2; ++ks)
#pragma unroll
            for (int et = 0; et < 4; ++et) cr[et] = __builtin_amdgcn_mfma_f32_16x16x32_bf16(qa[ks], sb[ks][et], cr[et], 0, 0, 0);
#pragma unroll
        for (int r = 0; r < 4; ++r) {
            const int i = i0 + fq * 4 + r; const float qd = exp2f((float)(i + 1) * lg2);
            float v[4]; float s = 0.f;
#pragma unroll
            for (int et = 0; et < 4; ++et) { v[et] = o[et][r] + cr[et][r] * qd; s += v[et]; }
            const float mean = red16(s) * (1.0f / 64.0f); float q = 0.f;
#pragma unroll
            for (int et = 0; et < 4; ++et) { v[et] -= mean; q += v[et] * v[et]; }
            const float rstd = 1.0f / sqrtf(red16(q) * (1.0f / 64.0f) + 1e-5f);
#pragma unroll
            for (int et = 0; et < 4; ++et) { const float g = bf2f(*(const LAS bf16_t*)(L + OG + i * 144 + (16 * et + fr) * 2));
                *(LAS bf16_t*)(L + OQ + i * 144 + (16 * et + fr) * 2) = f2bf(g * sigmoidf_(g) * (v[et] * rstd * gg[et] + gb[et])); }
        }
        asm volatile("s_waitcnt lgkmcnt(0)" ::: "memory");
#pragma unroll
        for (int x = 0; x < 2; ++x) { const int rr = lane >> 2, ch = (lane & 3) * 2 + x;
            const u32x4 ov = *(const LAS u32x4*)(L + OQ + (i0 + rr) * 144 + ch * 16);
            *(u32x4*)(MIX + ((size_t)b * SEQ + n * 128 + i0 + rr) * D + h * 64 + ch * 8) = ov; }
        __syncthreads();
    }
#undef RET_LOAD
}
struct SideP { const bf16_t* ZRW; const float* LW; const bf16_t* LA2; const bf16_t* LG; const float* mu; const float* k_k; const float* k_a; const float* r_k; const float* gn_g; const float* gn_b; bf16_t* MIX; };
DI void rounds_side(int bh, int tl_first, int tstep, int lane, int p, const SideP& P, float* SC, const float* YB) {
    const int b = bh >> 3, h = bh & 7, hc = h * 64 + lane;
    const float mu_r = P.mu[hc], mu_k = P.mu[512 + hc], mu_v = P.mu[1024 + hc], kkc = P.k_k[hc], kac = P.k_a[hc], rkc = P.r_k[hc], gg = P.gn_g[hc], gb = P.gn_b[hc];
    const bool do_post = p >= 2, do_prep = p < NR;
    for (int tl0 = tl_first; tl0 < TR; tl0 += 4 * tstep) {
        float pr[4], pk[4], pv[4], py[4], pg[4];
        float z0[4], z1[4], z2[4], q0[4], q1[4], q2[4], lw[4], la[4];
        if (do_post) {
#pragma unroll
            for (int j = 0; j < 4; ++j) { const int tl = tl0 + tstep * j; if (tl >= TR) continue; const size_t t = (size_t)b * SEQ + (p - 2) * TR + tl; const float* rec = SC + ((size_t)bh * TR + tl) * REC + lane;
                pr[j] = rec[0]; pk[j] = rec[128]; pv[j] = rec[320]; py[j] = YB[((size_t)bh * TR + tl) * 64 + lane]; pg[j] = bf2f(P.LG[t * 512 + hc]); }
        }
        if (do_prep) {
#pragma unroll
            for (int j = 0; j < 4; ++j) { if (tl0 + tstep * j >= TR) continue; const int tin = p * TR + tl0 + tstep * j; const size_t t = (size_t)b * SEQ + tin; const bf16_t* zr = P.ZRW + t * 2048 + hc;
                z0[j] = bf2f(zr[0]); z1[j] = bf2f(zr[512]); z2[j] = bf2f(zr[1024]);
                if (tin) { q0[j] = bf2f(zr[-2048]); q1[j] = bf2f(zr[512 - 2048]); q2[j] = bf2f(zr[1024 - 2048]); } else { q0[j] = 0.f; q1[j] = 0.f; q2[j] = 0.f; }
                lw[j] = P.LW[t * 512 + hc]; la[j] = bf2f(P.LA2[t * 512 + hc]); }
        }
        if (do_post) {
#pragma unroll
            for (int j = 0; j < 4; ++j) { const int tl = tl0 + tstep * j; if (tl >= TR) continue; const size_t t = (size_t)b * SEQ + (p - 2) * TR + tl;
                const float mean = wave_sum(py[j]) * (1.0f / 64.0f); const float dv = py[j] - mean; const float var = wave_sum(dv * dv) * (1.0f / 64.0f);
                const float yn = dv * (1.0f / sqrtf(var + 64e-5f)) * gg + gb; const float bonus = wave_sum(pr[j] * pk[j] * rkc) * pv[j];
                P.MIX[t * D + 512 + hc] = f2bf((yn + bonus) * pg[j]); }
        }
        if (do_prep) {
#pragma unroll
            for (int j = 0; j < 4; ++j) { const int tl = tl0 + tstep * j; if (tl >= TR) continue;
                const float r = z0[j] + (q0[j] - z0[j]) * mu_r, kr = z1[j] + (q1[j] - z1[j]) * mu_k, v = z2[j] + (q2[j] - z2[j]) * mu_v;
                const float w = decay_from_lora(lw[j]), a = sigmoidf_(la[j]);
                float kk = kr * kkc; const float n2 = wave_sum(kk * kk); kk = kk / fmaxf(sqrtf(n2), 1e-12f);
                float* rec = SC + ((size_t)bh * TR + tl) * REC + lane;
                rec[0] = r; rec[64] = w; rec[128] = kr * (1.0f + (a - 1.0f) * kac); rec[192] = kk; rec[256] = -(kk * a); rec[320] = v; }
        }
    }
}
struct StepIn { f32x4 r, w, k, kk, b; float v; };
DI float fma_(float a, float b, float c) { float d; asm("v_fma_f32 %0, %1, %2, %3" : "=v"(d) : "v"(a), "v"(b), "v"(c)); return d; }
DI float nfma_(float a, float b, float c) { float d; asm("v_fma_f32 %0, -%1, %2, %3" : "=v"(d) : "v"(a), "v"(b), "v"(c)); return d; }
DI float mul_(float a, float b) { float d; asm("v_mul_f32 %0, %1, %2" : "=v"(d) : "v"(a), "v"(b)); return d; }
#define RING_NB 4
DI unsigned lds_ld(volatile LAS unsigned* p) { return __hip_atomic_load((LAS unsigned*)p, __ATOMIC_RELAXED, __HIP_MEMORY_SCOPE_WORKGROUP); }
DI void lds_st(volatile LAS unsigned* p, unsigned v) { __hip_atomic_store((LAS unsigned*)p, v, __ATOMIC_RELAXED, __HIP_MEMORY_SCOPE_WORKGROUP); }
DI int scan_bh(int bx) { return (bx & 7) * 4 + (bx >> 6); }
DI void scan_loader(const Ctx& c, int round, const float* SC, volatile LAS unsigned* ctl) {
    const float* rec0 = SC + (size_t)scan_bh(c.bx) * TR * REC;
    const unsigned gb0 = (unsigned)round * (TR / 16);
    for (int blk = 0; blk < TR / 16; ++blk) {
        const unsigned gb = gb0 + blk;
        if (gb >= RING_NB) { while (min(lds_ld(ctl + 1), lds_ld(ctl + 2)) + RING_NB <= gb) __builtin_amdgcn_s_sleep(1); }
        asm volatile("" ::: "memory");
        LAS unsigned char* dst = c.lds + (gb % RING_NB) * 24576;
#pragma unroll
        for (int q = 0; q < 24; ++q)
            __builtin_amdgcn_global_load_lds((const unsigned*)(rec0 + (size_t)blk * 16 * REC + (q * 64 + c.lane) * 4), (LAS unsigned*)(dst + q * 1024), 16, 0, 0);
        if (blk > 0) { asm volatile("s_waitcnt vmcnt(24)" ::: "memory"); lds_st(ctl, gb); }
    }
    asm volatile("s_waitcnt vmcnt(0)" ::: "memory"); lds_st(ctl, gb0 + TR / 16);
}
DI void scan_round(const Ctx& c, int sw, int round, float* YB, float* ST, volatile LAS unsigned* ctl, bool keep = true) {
    const int bh = scan_bh(c.bx), rg = ((c.bx >> 3) & 7) * 2 + sw, kq = c.lane & 15, row = rg * 4 + (c.lane >> 4);
    float* y0 = YB + (size_t)bh * TR * 64;
    float* stp = ST + ((size_t)bh * 64 + row) * 64 + kq * 4;
    f32x4 S = (f32x4){0.f, 0.f, 0.f, 0.f};
    if (round) S = *(const f32x4*)stp;
    const unsigned gb0 = (unsigned)round * (TR / 16);
#define SCAN_LD(dst, s) do { const LAS unsigned char* ps_ = p + (s) * 1536; dst.r = *(const LAS f32x4*)(ps_ + kq * 16); dst.w = *(const LAS f32x4*)(ps_ + 256 + kq * 16); dst.k = *(const LAS f32x4*)(ps_ + 512 + kq * 16); \
        dst.kk = *(const LAS f32x4*)(ps_ + 768 + kq * 16); dst.b = *(const LAS f32x4*)(ps_ + 1024 + kq * 16); dst.v = *(const LAS float*)(ps_ + 1280 + row * 4); } while (0)
    unsigned seen = lds_ld(ctl);
    for (int blk = 0; blk < TR / 16; ++blk) {
        const unsigned gb = gb0 + blk;
        while (seen <= gb) { __builtin_amdgcn_s_sleep(1); seen = lds_ld(ctl); }
        asm volatile("" ::: "memory");
        const LAS unsigned char* p = c.lds + (gb % RING_NB) * 24576;
        float yp[16];
        StepIn cur, nxt, nx2; SCAN_LD(cur, 0); SCAN_LD(nxt, 1);
        f32x4 rprev = cur.r;
#pragma unroll
        for (int s = 0; s < 16; ++s) {
            if (s < 14) SCAN_LD(nx2, s + 2);
            if (s == 8) seen = lds_ld(ctl);
            float sa; { float a0 = mul_(S[0], cur.kk[0]), a1 = mul_(S[2], cur.kk[2]); a0 = fma_(S[1], cur.kk[1], a0); a1 = fma_(S[3], cur.kk[3], a1); asm("v_add_f32 %0, %1, %2" : "=v"(sa) : "v"(a0), "v"(a1)); }
            if (s > 0) { float y = S[0] * rprev[0]; y = fmaf(S[1], rprev[1], y); y = fmaf(S[2], rprev[2], y); y = fmaf(S[3], rprev[3], y); yp[s - 1] = y; }
            const f32x4 T = S * cur.w + cur.k * cur.v;
            sa = red16(sa);
            S = T + cur.b * sa;
            rprev = cur.r;
            if (s < 15) cur = nxt;
            if (s < 14) nxt = nx2;
        }
        { float y = S[0] * rprev[0]; y = fmaf(S[1], rprev[1], y); y = fmaf(S[2], rprev[2], y); y = fmaf(S[3], rprev[3], y); yp[15] = y; }
        float yk;
        {
            const bool b3 = (kq & 8) != 0, b2 = (kq & 4) != 0, b1 = (kq & 2) != 0, b0 = (kq & 1) != 0;
            float q8[8], q4[4], q2[2];
#pragma unroll
            for (int j = 0; j < 8; ++j) { const float keep = b3 ? yp[j + 8] : yp[j], send = b3 ? yp[j] : yp[j + 8]; q8[j] = keep + dpp_f<0x128>(send); }
#pragma unroll
            for (int j = 0; j < 4; ++j) { const float keep = b2 ? q8[j + 4] : q8[j], send = b2 ? q8[j] : q8[j + 4]; q4[j] = keep + dpp_f<0x141>(send); }
#pragma unroll
            for (int j = 0; j < 2; ++j) { const float keep = b1 ? q4[j + 2] : q4[j], send = b1 ? q4[j] : q4[j + 2]; q2[j] = keep + dpp_f<0x4E>(send); }
            { const float keep = b0 ? q2[1] : q2[0], send = b0 ? q2[0] : q2[1]; yk = keep + dpp_f<0xB1>(send); }
        }
        asm volatile("s_waitcnt lgkmcnt(0)" ::: "memory");
        lds_st(ctl + 1 + sw, gb + 1);
        y0[(size_t)(blk * 16 + kq) * 64 + row] = yk;
    }
#undef SCAN_LD
    if (keep) *(f32x4*)stp = S;
}

#define XB_TMO      128
#define XB_XCNT(j)  (256  + 64 * (j))
#define XB_XSUB(j)  (1280 + 64 * (j))
#define XB_XGEN(j)  (2304 + 64 * (j))
#define XB_TOP      3328
#define XB_TOPGEN   3392
#define XCD_BAR_WORDS 3456
#define XB_SPIN_CAP (1u << 18)

__device__ __forceinline__ unsigned xb_ld(unsigned* p)              { return __hip_atomic_load(p, __ATOMIC_RELAXED, __HIP_MEMORY_SCOPE_AGENT); }
__device__ __forceinline__ unsigned xb_add(unsigned* p, unsigned v) { return __hip_atomic_fetch_add(p, v, __ATOMIC_RELAXED, __HIP_MEMORY_SCOPE_AGENT); }
__device__ __forceinline__ unsigned xb_xcc_id() { return (unsigned)__builtin_amdgcn_s_getreg((3 << 11) | 20) & 0xFu; }
#define XB_SPIN(cond, bar) do { unsigned _sp = 0; while (cond) { __builtin_amdgcn_s_sleep(1); \
    if ((++_sp & 255u) == 0u) { if (xb_ld(&(bar)[XB_TMO])) break; if (_sp > XB_SPIN_CAP) { atomicAdd(&(bar)[XB_TMO], 1u); break; } } } } while (0)

struct XcdBarrier {
    unsigned* bar; unsigned x;
    volatile LAS unsigned* st;
};

__device__ __forceinline__ XcdBarrier xcd_barrier_post(unsigned* bar, volatile LAS unsigned* st) {
    XcdBarrier b; b.bar = bar; b.x = xb_xcc_id(); b.st = st;
    if (threadIdx.x == 0) (void)xb_add(&bar[XB_XCNT(b.x)], 1u);
    return b;
}
__device__ __forceinline__ void xcd_barrier_complete(unsigned* bar, unsigned x, unsigned& nloc, unsigned& nx) {
    const unsigned G = gridDim.x * gridDim.y * gridDim.z;
    unsigned sum, cnt, mine, sp = 0u;
    for (;;) {
        sum = 0u; cnt = 0u; mine = 0u;
#pragma unroll
        for (unsigned j = 0; j < 16; ++j) { const unsigned c = xb_ld(&bar[XB_XCNT(j)]); sum += c; cnt += (c > 0u) ? 1u : 0u; mine = (j == x) ? c : mine; }
        if (sum == G) break;
        __builtin_amdgcn_s_sleep(1);
        if ((++sp & 255u) == 0u) { if (xb_ld(&bar[XB_TMO])) break; if (sp > XB_SPIN_CAP) { atomicAdd(&bar[XB_TMO], 1u); break; } }
    }
    nloc = mine > 0u ? mine : 1u; nx = cnt > 0u ? cnt : 1u;
}

__device__ __forceinline__ void xcd_barrier(const XcdBarrier& b) {
    asm volatile("s_waitcnt vmcnt(0)" ::: "memory");
    __syncthreads();
    if (threadIdx.x == 0) {
        unsigned* bar = b.bar;
        __builtin_amdgcn_s_waitcnt(0);
        unsigned nloc = b.st[0], nx = b.st[1];
        if (nloc == 0u) { xcd_barrier_complete(bar, b.x, nloc, nx); b.st[0] = nloc; b.st[1] = nx; }
        const unsigned old = xb_add(&bar[XB_XSUB(b.x)], 1u);
        const unsigned gen = old / nloc;
        if (old + 1u == (gen + 1u) * nloc) {
            __builtin_amdgcn_fence(__ATOMIC_RELEASE, "agent");
            asm volatile("s_waitcnt vmcnt(0)" ::: "memory");
            const unsigned og = xb_add(&bar[XB_TOP], 1u);
            const unsigned tg = og / nx;
            if (og + 1u == (tg + 1u) * nx) xb_add(&bar[XB_TOPGEN], 1u);
            else XB_SPIN(xb_ld(&bar[XB_TOPGEN]) == tg, bar);
            __builtin_amdgcn_fence(__ATOMIC_ACQUIRE, "agent");
            xb_add(&bar[XB_XGEN(b.x)], 1u);
            asm volatile("s_waitcnt vmcnt(0)" ::: "memory");
        } else {
            XB_SPIN(xb_ld(&bar[XB_XGEN(b.x)]) == gen, bar);
            __builtin_amdgcn_fence(__ATOMIC_ACQUIRE, "agent");
            asm volatile("s_waitcnt vmcnt(0)" ::: "memory");
        }
    }
    __syncthreads();
}

struct Args { const float* in[30]; float* out; unsigned char* ws; int ph_lo, ph_hi; };
enum { I_X = 0, I_P, I_F1GU, I_F1D, I_LN1G, I_LN1B, I_WIN, I_RGNG, I_RGNB, I_MU, I_W0, I_WUP, I_A0, I_AUP, I_GUP, I_KK, I_KA, I_RK, I_WGNG, I_WGNB, I_WOUT, I_LN2G, I_LN2B,
       I_F2GU, I_F2D, I_LN3G, I_LN3B, I_PPROJ, I_PGATE, I_PBIAS };

#define CAS __attribute__((address_space(4)))
#define PHASE_BEGIN(k) if (ph_lo <= (k) && (k) < ph_hi) { \
        int tid_ = threadIdx.x; asm volatile("" : "+v"(tid_)); \
        Ctx c; c.lds = (LAS unsigned char*)lds_raw; c.tid = tid_; c.lane = c.tid & 63; c.wave = __builtin_amdgcn_readfirstlane(c.tid >> 6); \
        c.bx = blockIdx.x; c.G = gridDim.x; c.gw = c.bx * 8 + c.wave; c.NGW = c.G * 8; c.gtid = c.bx * 512 + c.tid; c.NGT = c.G * 512; \
        const CAS Args* ap = (const CAS Args*)__builtin_amdgcn_kernarg_segment_ptr(); asm volatile("" : "+s"(ap)); const CAS Args& a = *ap; unsigned char* ws = a.ws; (void)ws;
#define PHASE_END(k) if ((k) + 1 < ph_hi) xcd_barrier(bar); }
#define P_(T, name, off) T* name = (T*)(ws + (off))

#define GEMM_GU(Aptr, statp, c1p, c2p) do { P_(bf16_t, Wgu_t, WS_WGU); P_(bf16_t, H, WS_A); \
        pg8::Gemm g{Aptr, Wgu_t, M, NGU, D}; pg8::StaticOrder S; S.init(M, NGU, c.G, c.bx); EpiGU E{H, statp, c1p, c2p}; \
        pg8::gemm_phase<EpiGU, pg8::StaticOrder, PG_ALIGN, true>(c.lds, g, S, E, c.tid); } while (0)
#define GEMM_RES(Aptr, Wptr, Kdim, Xraw, Yio, YBp, stat_out, ln_stat, lng, lnb, scale) do { \
        pg8::Gemm g{Aptr, Wptr, M, D, Kdim}; pg8::StaticOrder S; S.init(M, D, c.G, c.bx); EpiRes E{Xraw, Yio, YBp, stat_out, ln_stat, lng, lnb, scale}; \
        pg8::gemm_phase<EpiRes, pg8::StaticOrder, PG_ALIGN, true>(c.lds, g, S, E, c.tid); } while (0)
DI void ln_tail(const Ctx& c, int inst, const float* Y, const float* g, const float* b, float* XF, bf16_t* XB, unsigned* cnt_base) {
    pg8::StaticOrder S; S.init(M, D, c.G, c.bx); pg8::Unit u;
    if (!S.next(0, u)) return;
    unsigned* cnt = cnt_base + inst * 64 + u.pm;
    asm volatile("s_waitcnt vmcnt(0)" ::: "memory");
    __syncthreads();
    if (c.tid == 0) {
        __builtin_amdgcn_fence(__ATOMIC_RELEASE, "agent");
        asm volatile("s_waitcnt vmcnt(0)" ::: "memory");
        __hip_atomic_fetch_add(cnt, 1u, __ATOMIC_RELAXED, __HIP_MEMORY_SCOPE_AGENT);
        unsigned sp = 0;
        while (__hip_atomic_load(cnt, __ATOMIC_RELAXED, __HIP_MEMORY_SCOPE_AGENT) < 4u) { __builtin_amdgcn_s_sleep(1); if (++sp > (1u << 22)) break; }
        __builtin_amdgcn_fence(__ATOMIC_ACQUIRE, "agent");
        asm volatile("s_waitcnt vmcnt(0)" ::: "memory");
    }
    __syncthreads();
    const int lane = c.lane;
    const f32x4 g0 = ((const f32x4*)g)[lane], g1 = ((const f32x4*)g)[lane + 64], g2 = ((const f32x4*)g)[lane + 128], g3 = ((const f32x4*)g)[lane + 192];
    const f32x4 b0 = ((const f32x4*)b)[lane], b1 = ((const f32x4*)b)[lane + 64], b2 = ((const f32x4*)b)[lane + 128], b3 = ((const f32x4*)b)[lane + 192];
    for (int rr = c.wave; rr < 64; rr += 8) {
        const int m = u.pm * 256 + u.pn * 64 + rr;
        const f32x4* yr = (const f32x4*)(Y + (size_t)m * D) + lane;
        f32x4 v0 = yr[0], v1 = yr[64], v2 = yr[128], v3 = yr[192];
        float sm = (v0[0] + v0[1] + v0[2] + v0[3]) + (v1[0] + v1[1] + v1[2] + v1[3]) + (v2[0] + v2[1] + v2[2] + v2[3]) + (v3[0] + v3[1] + v3[2] + v3[3]);
        const float mean = wave_sum(sm) * (1.0f / D);
        v0 = v0 - mean; v1 = v1 - mean; v2 = v2 - mean; v3 = v3 - mean;
        float q = (v0[0] * v0[0] + v0[1] * v0[1] + v0[2] * v0[2] + v0[3] * v0[3]) + (v1[0] * v1[0] + v1[1] * v1[1] + v1[2] * v1[2] + v1[3] * v1[3])
                + (v2[0] * v2[0] + v2[1] * v2[1] + v2[2] * v2[2] + v2[3] * v2[3]) + (v3[0] * v3[0] + v3[1] * v3[1] + v3[2] * v3[2] + v3[3] * v3[3]);
        const float rstd = 1.0f / sqrtf(wave_sum(q) * (1.0f / D) + 1e-5f);
        v0 = v0 * rstd * g0 + b0; v1 = v1 * rstd * g1 + b1; v2 = v2 * rstd * g2 + b2; v3 = v3 * rstd * g3 + b3;
        f32x4* xo = (f32x4*)(XF + (size_t)m * D) + lane; xo[0] = v0; xo[64] = v1; xo[128] = v2; xo[192] = v3;
        u32x2* bo = (u32x2*)(XB + (size_t)m * D) + lane; u32x2 o;
        o.x = cvt_pk_bf16(v0[0], v0[1]); o.y = cvt_pk_bf16(v0[2], v0[3]); bo[0] = o;
        o.x = cvt_pk_bf16(v1[0], v1[1]); o.y = cvt_pk_bf16(v1[2], v1[3]); bo[64] = o;
        o.x = cvt_pk_bf16(v2[0], v2[1]); o.y = cvt_pk_bf16(v2[2], v2[3]); bo[128] = o;
        o.x = cvt_pk_bf16(v3[0], v3[1]); o.y = cvt_pk_bf16(v3[2], v3[3]); bo[192] = o;
    }
}
#define LN_TAIL(inst, gi) do { P_(float, Yt, WS_B); P_(bf16_t, XBt, WS_XB); ln_tail(c, inst, Yt, a.in[gi], a.in[(gi) + 1], a.out, XBt, (unsigned*)(ws + 14336)); } while (0)
#define LN_ROWS(gi) do { P_(float, Y, WS_B); P_(bf16_t, XB, WS_XB); layer_norm_rows(c, Y, a.in[gi], a.in[(gi) + 1], a.out, XB); if (DUP_MISC > 1) layer_norm_rows(c, Y, a.in[gi], a.in[(gi) + 1], a.out, XB); } while (0)

__global__ void __launch_bounds__(512, 2) mk_fwd(Args a_kernarg) {
    extern __shared__ __attribute__((aligned(16))) unsigned char lds_raw[];
    cg::grid_group grid = cg::this_grid();
    const int ph_lo = ((const CAS Args*)__builtin_amdgcn_kernarg_segment_ptr())->ph_lo, ph_hi = ((const CAS Args*)__builtin_amdgcn_kernarg_segment_ptr())->ph_hi;
    if (threadIdx.x < 32) ((volatile LAS unsigned*)((LAS unsigned char*)lds_raw + 135 * 1024))[threadIdx.x] = 0u;
    __syncthreads();
    XcdBarrier bar; bar.bar = nullptr; bar.x = 0; bar.st = nullptr;
    if (ph_hi - ph_lo > 1) bar = xcd_barrier_post((unsigned*)((const CAS Args*)__builtin_amdgcn_kernarg_segment_ptr())->ws, (volatile LAS unsigned*)((LAS unsigned char*)lds_raw + 135 * 1024));
    if (ph_hi > NPH) grid.sync();
    constexpr int PH_ROUND0 = 8, PH_WOUT = 8 + NR + 2;

    PHASE_BEGIN(0)
        P_(bf16_t, Wgu_t, WS_WGU); P_(bf16_t, Wd_t, WS_WD); P_(bf16_t, XB, WS_XB);
        { LAS float* scr0 = (LAS float*)(c.lds + c.wave * 8448);
          for (int it = c.gw; it < 2816; it += c.NGW) { const int kb = it / 176, nb = it % 176; transpose_item(a.in[I_F1GU], NGU, Wgu_t, D, gu_dst_row(32 * nb), 64 * kb, 32 * nb, scr0, c.lane); } }
        for (int i = c.gtid; i < (int)((WS_ZERO_BYTES - WS_C1WIN) / 16); i += c.NGT) ((u32x4*)(ws + WS_C1WIN))[i] = (u32x4){0u, 0u, 0u, 0u};
        cvt_rows_bf16(c, a.in[I_X], XB, (size_t)M * D / 4);
    PHASE_END(0)
#define RSTAT(i) ((float*)(ws + WS_RSTAT) + (size_t)(i) * 2 * M)
    PHASE_BEGIN(1) {
        { P_(bf16_t, XB, WS_XB); GEMM_GU(XB, (const float*)nullptr, (const float*)nullptr, (const float*)nullptr); }
        if (c.bx >= c.G / 2) {
            P_(bf16_t, Win_t, WS_WIN); P_(bf16_t, Wlora_t, WS_WLORA); P_(bf16_t, Wout_t, WS_WOUT); P_(float, CS, WS_CS);
            const int gw2 = (c.bx - c.G / 2) * 8 + c.wave, ngw2 = (c.G / 2) * 8, gt2 = (c.bx - c.G / 2) * 512 + c.tid, ngt2 = (c.G / 2) * 512;
            LAS float* scr = (LAS float*)(c.lds + c.wave * 8448);
            { P_(bf16_t, Wd_t, WS_WD); for (int it = gw2; it < 1408; it += ngw2) { const int kb = it / 32, nb = it % 32; transpose_item(a.in[I_F1D], D, Wd_t, FF, 32 * nb, 64 * kb, 32 * nb, scr, c.lane); } }
            for (int it = gw2; it < 1936 + 512; it += ngw2) {
                if (it < 1936) { const int kb = it / 121, nb = it % 121; transpose_item(a.in[I_WIN], NIN, Win_t, D, win_dst_row(32 * nb), 64 * kb, 32 * nb, scr, c.lane, a.in[I_LN1G], a.in[I_LN1B], (float*)(ws + WS_C1WIN), (float*)(ws + WS_C2WIN)); }
                else { const int r = it - 1936, kb = r / 32, nb = r % 32; transpose_item(a.in[I_WOUT], D, Wout_t, D, 32 * nb, 64 * kb, 32 * nb, scr, c.lane); }
            }
            for (int i = gt2; i < (NINP - NIN) * D / 8; i += ngt2) ((u32x4*)(Win_t + (size_t)NIN * D))[i] = (u32x4){0u, 0u, 0u, 0u};
            for (int i = gt2; i < NL * (KL / 8); i += ngt2) {
                const int kg = i / NL, n = i % NL, k0 = 8 * kg; u32x4 o = (u32x4){0u, 0u, 0u, 0u};
                const float* src = nullptr;
                if (n < 512) { if (k0 < 64) src = a.in[I_WUP] + (size_t)k0 * 512 + n; }
                else if (n < 1024) { if (k0 >= 64 && k0 < 128) src = a.in[I_AUP] + (size_t)(k0 - 64) * 512 + (n - 512); }
                else { if (k0 >= 128 && k0 < 288) src = a.in[I_GUP] + (size_t)(k0 - 128) * 512 + (n - 1024); }
                if (src) { o.x = cvt_pk_bf16(src[0], src[512]); o.y = cvt_pk_bf16(src[1024], src[1536]); o.z = cvt_pk_bf16(src[2048], src[2560]); o.w = cvt_pk_bf16(src[3072], src[3584]); }
                *(u32x4*)(Wlora_t + (size_t)n * KL + k0) = o;
            }
            for (int i = gt2; i < SEQ * 32; i += ngt2) {
                const int pos = i >> 5, f = i & 31; double pw = 1.0; for (int j = 0; j < f; ++j) pw *= 0.7498942093324559;
                const float invf = (float)pw; const float ang = (float)pos * invf;
                double r = (double)ang; r -= 6.283185307179586 * __builtin_rint(r * 0.15915494309189535); const double x = r * 0.25, x2 = x * x;
                double sn = x * (1.0 + x2 * (-1.0 / 6 + x2 * (1.0 / 120 + x2 * (-1.0 / 5040 + x2 * (1.0 / 362880 + x2 * (-1.0 / 39916800 + x2 * (1.0 / 6227020800.0)))))));
                double cn = 1.0 + x2 * (-0.5 + x2 * (1.0 / 24 + x2 * (-1.0 / 720 + x2 * (1.0 / 40320 + x2 * (-1.0 / 3628800 + x2 * (1.0 / 479001600.0 + x2 * (-1.0 / 87178291200.0)))))));
                double s2 = 2.0 * sn * cn, c2 = 1.0 - 2.0 * sn * sn; sn = 2.0 * s2 * c2; cn = 1.0 - 2.0 * s2 * s2;
                CS[2 * i] = (float)cn; CS[2 * i + 1] = (float)sn;
            }
        }
    } PHASE_END(1)
    PHASE_BEGIN(2) { P_(bf16_t, H, WS_A); P_(bf16_t, Wd_t, WS_WD); P_(bf16_t, XB, WS_XB);
        GEMM_RES(H, Wd_t, FF, a.in[I_X], a.out, XB, RSTAT(0), (const float*)nullptr, (const float*)nullptr, (const float*)nullptr, 0.5f); } PHASE_END(2)
    PHASE_BEGIN(3) {
        P_(bf16_t, XB, WS_XB); P_(bf16_t, Win_t, WS_WIN); P_(bf16_t, ZRET, WS_A); P_(bf16_t, ZRW, WS_B); P_(float, CS, WS_CS);
        pg8::Gemm g{XB, Win_t, M, NINP, D}; pg8::StaticOrder S; S.init(M, NINP, c.G, c.bx); EpiWin E{ZRET, ZRW, CS, RSTAT(0), (const float*)(ws + WS_C1WIN), (const float*)(ws + WS_C2WIN)};
        pg8::gemm_phase<EpiWin, pg8::StaticOrder, PG_ALIGN, true>(c.lds, g, S, E, c.tid);
    } PHASE_END(3)
    PHASE_BEGIN(4) {
        P_(bf16_t, ZRET, WS_A); P_(bf16_t, ZRW, WS_B); P_(bf16_t, LA, WS_A + 64 * MiB); P_(bf16_t, MIX, WS_XB);
        prep_lora_a(c, ZRW, a.in[I_MU], LA);
#ifdef DUP_PREPA
        prep_lora_a(c, ZRW, a.in[I_MU], LA);
#endif
        { P_(float, KV, WS_SC); ret_kv(c, ZRET, KV); }
    } PHASE_END(4)
    PHASE_BEGIN(5) { P_(float, KV, WS_SC); P_(bf16_t, PS, WS_PB); ret_prefix(c, KV, PS); } PHASE_END(5)
    PHASE_BEGIN(6) { P_(bf16_t, ZRET, WS_A); P_(bf16_t, PS, WS_PB); P_(bf16_t, MIXr, WS_XB); ret_out(c, ZRET, PS, a.in[I_RGNG], a.in[I_RGNB], MIXr); } PHASE_END(6)
    PHASE_BEGIN(7) {
        P_(bf16_t, LA, WS_A + 64 * MiB); P_(bf16_t, Wlora_t, WS_WLORA); P_(float, LW, WS_A); P_(bf16_t, LA2, WS_A + 32 * MiB); P_(bf16_t, LG, WS_A + 48 * MiB);
        int kdim = KL; asm volatile("" : "+s"(kdim)); pg8::Gemm g{LA, Wlora_t, M, NL, kdim}; pg8::StaticOrder S; S.init(M, NL, c.G, c.bx); EpiLora E{LW, LA2, LG, a.in[I_W0], a.in[I_A0]};
        pg8::gemm_phase<EpiLora, pg8::StaticOrder, PG_ALIGN, true>(c.lds, g, S, E, c.tid);
#if DUP_GEMM > 1
        __syncthreads(); pg8::gemm_phase<EpiLora, pg8::StaticOrder, PG_ALIGN, true>(c.lds, g, S, E, c.tid);
#endif
    } PHASE_END(7)
    for (int p = 0; p < NR + 2; ++p) {
        PHASE_BEGIN(PH_ROUND0 + p) {
            P_(float, ST, WS_ST); P_(float, YBA, WS_PB);
            float* SCb[2] = {(float*)(ws + WS_SC), (float*)(ws + WS_A + 64 * MiB)};
            float* SCw = (p & 1) ? SCb[1] : SCb[0]; float* SCr = (p & 1) ? SCb[0] : SCb[1];
            float* YBw = YBA + (size_t)((p & 1) ^ 1) * (32 * TR * 64); float* YBr = YBA + (size_t)(p & 1) * (32 * TR * 64);
            volatile LAS unsigned* ctl = (volatile LAS unsigned*)(c.lds + 135 * 1024 + 64);
            if ((p == 0 || p == NR + 1) && (c.wave == 0 || c.wave == 2 || c.wave == 5)) {
                P_(bf16_t, Wgu_t, WS_WGU); P_(bf16_t, Wd_t, WS_WD);
                LAS float* scr = (LAS float*)(c.lds + c.wave * 8448);
                const int widx = c.bx * 3 + (c.wave == 0 ? 0 : (c.wave == 2 ? 1 : 2)), lo_it = p == 0 ? 0 : 2112, hi_it = p == 0 ? 2112 : 4224;
                for (int it = lo_it + widx; it < hi_it; it += c.G * 3) {
                    if (it < 2816) { const int kb = it / 176, nb = it % 176; transpose_item(a.in[I_F2GU], NGU, Wgu_t, D, gu_dst_row(32 * nb), 64 * kb, 32 * nb, scr, c.lane, a.in[I_LN2G], a.in[I_LN2B], (float*)(ws + WS_C1GU), (float*)(ws + WS_C2GU)); }
                    else { const int r = it - 2816, kb = r / 32, nb = r % 32; transpose_item(a.in[I_F2D], D, Wd_t, FF, 32 * nb, 64 * kb, 32 * nb, scr, c.lane); }
                }
            } else if (c.wave == 0 || c.wave == 5) {
#ifdef DUP_SCAN
                if (p >= 1 && p <= NR) scan_round(c, c.wave ? 1 : 0, p - 1, YBw, ST, ctl, false);
#endif
                __builtin_amdgcn_s_setprio(3);
                if (p >= 1 && p <= NR) scan_round(c, c.wave ? 1 : 0, p - 1, YBw, ST, ctl);
                __builtin_amdgcn_s_setprio(0);
            } else if (c.wave == 2) {
                if (p >= 1 && p <= NR) scan_loader(c, p - 1, SCr, ctl);
            } else {
                P_(bf16_t, ZRW, WS_B); P_(float, LW, WS_A); P_(bf16_t, LA2, WS_A + 32 * MiB); P_(bf16_t, LG, WS_A + 48 * MiB); P_(bf16_t, MIX, WS_XB);
                const int sidx = c.wave == 1 ? 0 : (c.wave == 3 ? 1 : (c.wave == 4 ? 2 : c.wave - 3));
                const int lw = (c.bx >> 3) * 5 + sidx;
                const int sbh = (c.bx & 7) * 4 + (lw & 3), tl_first = lw >> 2, tstep = (c.G >> 3) * 5 / 4;
                SideP SP{ZRW, LW, LA2, LG, a.in[I_MU], a.in[I_KK], a.in[I_KA], a.in[I_RK], a.in[I_WGNG], a.in[I_WGNB], MIX};
                rounds_side(sbh, tl_first, tstep, c.lane, p, SP, SCw, YBr);
            }
        } PHASE_END(PH_ROUND0 + p)
    }
    PHASE_BEGIN(PH_WOUT) {
        { P_(bf16_t, MIX, WS_XB); P_(bf16_t, Wout_t, WS_WOUT); P_(bf16_t, YB2, WS_B);
          GEMM_RES(MIX, Wout_t, D, (const float*)nullptr, a.out, YB2, RSTAT(1), (const float*)RSTAT(0), a.in[I_LN1G], a.in[I_LN1B], 1.0f); }
        { P_(bf16_t, Wpp_t, WS_WPP); P_(bf16_t, PB, WS_PB); LAS float* scr = (LAS float*)(c.lds + c.wave * 8448);
          for (int it = c.gw; it < 128; it += c.NGW) { const int kb = it / 32, nb = it % 32; transpose_item(a.in[I_PPROJ], D, Wpp_t, DP, 32 * nb, 64 * kb, 32 * nb, scr, c.lane); }
          cvt_rows_bf16(c, a.in[I_P], PB, (size_t)M * DP / 4); }
    } PHASE_END(PH_WOUT)
    PHASE_BEGIN(PH_WOUT + 1) {
        { P_(bf16_t, YB2, WS_B); GEMM_GU(YB2, (const float*)RSTAT(1), (const float*)(ws + WS_C1GU), (const float*)(ws + WS_C2GU)); }
        if (c.bx >= c.G / 2) {
            P_(bf16_t, Wpg_t, WS_WPG); P_(bf16_t, Wpp_t, WS_WPP); P_(bf16_t, PB, WS_PB); P_(bf16_t, PROJ, WS_XB);
            const int gw2 = (c.bx - c.G / 2) * 8 + c.wave, ngw2 = (c.G / 2) * 8;
            LAS float* scr = (LAS float*)(c.lds + c.wave * 8448);
            for (int it = gw2; it < 512; it += ngw2) { const int kb = it / 32, nb = it % 32; transpose_item(a.in[I_PGATE], D, Wpg_t, D, 32 * nb, 64 * kb, 32 * nb, scr, c.lane, a.in[I_LN3G], a.in[I_LN3B], (float*)(ws + WS_C1PG), (float*)(ws + WS_C2PG)); }
            __syncthreads();
            { int kdim = DP; asm volatile("" : "+s"(kdim)); const int t3 = launder_v(c.tid); pg8::Gemm g{PB, Wpp_t, M, D, kdim}; pg8::StaticOrder S; S.init(M, D, c.G / 2, c.bx - c.G / 2); EpiProj E{PROJ};
              pg8::gemm_phase<EpiProj, pg8::StaticOrder, PG_ALIGN, true>(c.lds, g, S, E, t3); }
        }
    } PHASE_END(PH_WOUT + 1)
    PHASE_BEGIN(PH_WOUT + 2) { P_(bf16_t, H, WS_A); P_(bf16_t, Wd_t, WS_WD); P_(bf16_t, YB3, WS_B);
        GEMM_RES(H, Wd_t, FF, (const float*)nullptr, a.out, YB3, RSTAT(2), (const float*)RSTAT(1), a.in[I_LN2G], a.in[I_LN2B], 0.5f); } PHASE_END(PH_WOUT + 2)
    PHASE_BEGIN(PH_WOUT + 3) {
        P_(bf16_t, YB3, WS_B); P_(bf16_t, Wpg_t, WS_WPG); P_(bf16_t, PROJ, WS_XB);
        { pg8::Gemm g{YB3, Wpg_t, M, D, D}; pg8::StaticOrder S; S.init(M, D, c.G, c.bx);
          EpiGate E{a.out, PROJ, a.in[I_PBIAS], RSTAT(2), (const float*)(ws + WS_C1PG), (const float*)(ws + WS_C2PG), a.in[I_LN3G], a.in[I_LN3B]};
          pg8::gemm_phase<EpiGate, pg8::StaticOrder, PG_ALIGN, true>(c.lds, g, S, E, c.tid); }
    } PHASE_END(PH_WOUT + 3)
}

#ifndef MK_SPLIT
#define MK_SPLIT 0
#endif
extern "C" void kernel_launch(void* const* d_in, const int* in_sizes, int n_in, void* d_out, int out_size, void* d_ws, size_t ws_size, hipStream_t stream) {
    static int ready = 0;
    if (!ready) {
        if (n_in != 30 || out_size != M * D || ws_size < WS_END) { fprintf(stderr, "kernel_launch: unexpected problem (n_in %d out %d ws %zu)\n", n_in, out_size, ws_size); ready = -1; return; }
        if (hipFuncSetAttribute((const void*)mk_fwd, hipFuncAttributeMaxDynamicSharedMemorySize, LDS_BYTES) != hipSuccess) { fprintf(stderr, "kernel_launch: hipFuncSetAttribute failed\n"); ready = -1; return; }
        int per_cu = 0; (void)hipOccupancyMaxActiveBlocksPerMultiprocessor(&per_cu, (const void*)mk_fwd, 512, LDS_BYTES); (void)hipGetLastError();
        ready = 1;
    }
    if (ready < 0) return;
    if (hipMemsetAsync(d_ws, 0, 16384, stream) != hipSuccess) { fprintf(stderr, "kernel_launch: memset failed\n"); return; }
    Args a{};
    for (int i = 0; i < 30; ++i) a.in[i] = (const float*)d_in[i];
    a.out = (float*)d_out; a.ws = (unsigned char*)d_ws;
#if MK_SPLIT
    for (int ph = 0; ph < NPH; ++ph) { a.ph_lo = ph; a.ph_hi = ph + 1; hipLaunchKernelGGL(mk_fwd, dim3(256), dim3(512), LDS_BYTES, stream, a); }
#else
    a.ph_lo = 0; a.ph_hi = NPH;
    void* args[] = {&a};
    hipError_t e = hipLaunchCooperativeKernel((const void*)mk_fwd, dim3(256), dim3(512), args, LDS_BYTES, stream);
    if (e != hipSuccess) fprintf(stderr, "kernel_launch: cooperative launch failed: %s\n", hipGetErrorString(e));
#endif
}
```

```cpp
#include <hip/hip_runtime.h>
#include <hip/hip_cooperative_groups.h>
#include <cstdio>
#include <cstdint>
namespace cg = cooperative_groups;
namespace pg8 {
#define PG8_LAS __attribute__((address_space(3)))
typedef unsigned short bf16_t;
typedef short bf16x8 __attribute__((ext_vector_type(8)));
typedef float f32x4 __attribute__((ext_vector_type(4)));
typedef unsigned u32x4 __attribute__((ext_vector_type(4)));
constexpr int BM = 256, BK = 64, HALF = 128, HTB = HALF * BK * 2  , STAGE_BYTES = 8 * HTB, NXCD = 8, WGM = 4;

__host__ __device__ __forceinline__ int lds_byte(int r, int c) { const int st = (r >> 4) * 2 + (c >> 5), rr = r & 15, cc = c & 31, ob = rr * 64 + cc * 2; return st * 1024 + (ob ^ (((ob >> 9) & 1) << 5)); }
__host__ __device__ __forceinline__ void stage_rc(int b, int& R, int& C) { const int st = b / 1024, sb = b % 1024, swz = sb ^ (((sb >> 9) & 1) << 5); R = (st >> 1) * 16 + swz / 64; C = (st & 1) * 32 + (swz % 64) / 2; }
__host__ __device__ __forceinline__ int perm32(int rho) { const int n = rho >> 4, i = rho & 15; return 8 * (i >> 2) + 4 * n + (i & 3); }

struct Unit { int pm, pn; };
struct Gemm { const bf16_t* A; const bf16_t* Bt; int M, N, K; };

struct StaticOrder {
    int nM, nN, nwg, G, c;
    __host__ __device__ void init(int M, int N, int G_, int c_) { nM = M / BM; nN = N / BM; nwg = nM * nN; G = G_; c = c_; }
    __host__ __device__ bool next(int i, Unit& u) const {
        const long L = (long)i * G + c; if (L >= nwg) return false;
        int wgid = (int)L; { const int q = nwg / NXCD, r = nwg % NXCD, xcd = wgid % NXCD, off = wgid / NXCD; wgid = (xcd < r ? xcd * (q + 1) : r * (q + 1) + (xcd - r) * q) + off; }
        const int nig = WGM * nN, gid = wgid / nig, fm = gid * WGM, gsz = (nM - fm) < WGM ? (nM - fm) : WGM;
        u.pm = fm + ((wgid % nig) % gsz); u.pn = (wgid % nig) / gsz; return true;
    }
    __device__ __forceinline__ void a_ready(const Unit&) const {}
    __device__ __forceinline__ void done(const Unit&) const {}
};

__device__ __forceinline__ unsigned cvt_pk_bf16(float lo, float hi) { unsigned r; asm volatile("v_cvt_pk_bf16_f32 %0, %1, %2" : "=v"(r) : "v"(lo), "v"(hi)); return r; }
typedef float f32x2 __attribute__((ext_vector_type(2)));
template <class Epi, class Sched, bool ALIGN_EPI = false, bool SP2 = false>
__device__ __forceinline__ void gemm_phase(PG8_LAS unsigned char* lds, const Gemm g, const Sched& S, const Epi& E, const int tid) {
    const int wid = __builtin_amdgcn_readfirstlane(tid >> 6), lane = tid & 63, wr = wid >> 2, wc = wid & 3, fr = lane & 15, fq = lane >> 4;
    const int K = g.K, nt = K / BK;
    unsigned voffA[2], voffB[2];
#pragma unroll
    for (int i = 0; i < 2; ++i) { int R, C; stage_rc(tid * 16 + i * 8192, R, C); const int Rb = Epi::PERM ? ((R & ~31) + perm32(R & 31)) : R;
        voffA[i] = (unsigned)(R * K + C) * 2u; voffB[i] = (unsigned)(Rb * K + C) * 2u; }
    const size_t kstep = (size_t)(BK * 2);
    const size_t hstep = (size_t)HALF * K * 2;
    const size_t tstep = 2 * hstep;
    const unsigned ldsw = (unsigned)wid * 1024u;
    const int aoff = lds_byte(wr * 64 + fr, fq * 8), boff = lds_byte(wc * 32 + fr, fq * 8);
#define PG8_SA(b, h) (((b) * 2 + (h)) * HTB)
#define PG8_SB(b, h) ((4 + (b) * 2 + (h)) * HTB)
#define PG8_STAGE(bufoff, gbase, voff) do { _Pragma("unroll") for (int _i = 0; _i < 2; ++_i) \
        __builtin_amdgcn_global_load_lds((const unsigned*)((const char*)(gbase) + (voff)[_i]), (PG8_LAS unsigned*)(lds + (bufoff) + ldsw + _i * 8192), 16, 0, 0); } while (0)
#define PG8_LDA(dst, b, h) do { _Pragma("unroll") for (int m = 0; m < 4; ++m) _Pragma("unroll") for (int k = 0; k < 2; ++k) dst[m][k] = *(const PG8_LAS bf16x8*)(lds + PG8_SA(b, h) + aoff + m * 2048 + k * 1024); } while (0)
#define PG8_LDB(dst, b, h) do { _Pragma("unroll") for (int n = 0; n < 2; ++n) _Pragma("unroll") for (int k = 0; k < 2; ++k) dst[n][k] = *(const PG8_LAS bf16x8*)(lds + PG8_SB(b, h) + boff + n * 2048 + k * 1024); } while (0)
#define PG8_MMA(ai, bj, At, Bt) do { __builtin_amdgcn_s_setprio(1); _Pragma("unroll") for (int m = 0; m < 4; ++m) _Pragma("unroll") for (int n = 0; n < 2; ++n) _Pragma("unroll") for (int k = 0; k < 2; ++k) \
        acc[ai][bj][m][n] = __builtin_amdgcn_mfma_f32_16x16x32_bf16(Bt[n][k], At[m][k], acc[ai][bj][m][n], 0, 0, 0); __builtin_amdgcn_s_setprio(0); } while (0)
#define PG8_WAIT_V(n) asm volatile("s_waitcnt vmcnt(" #n ")" ::: "memory")
#define PG8_WAIT_L(n) asm volatile("s_waitcnt lgkmcnt(" #n ")" ::: "memory")
#define PG8_BAR __builtin_amdgcn_s_barrier()
#define PG8_SCHED __builtin_amdgcn_sched_barrier(0)
    Unit cur, nxt; int ui = 0;
    if (!S.next(0, cur)) return;
    f32x4 acc[2][2][4][2];
#pragma unroll
    for (int a = 0; a < 2; ++a)
#pragma unroll
        for (int b = 0; b < 2; ++b)
#pragma unroll
            for (int m = 0; m < 4; ++m)
#pragma unroll
                for (int n = 0; n < 2; ++n) acc[a][b][m][n] = (f32x4){0.f, 0.f, 0.f, 0.f};
    bf16x8 At[4][2], B0[2][2], B1[2][2];
    const char* cA = (const char*)g.A + (size_t)cur.pm * tstep; const char* cB = (const char*)g.Bt + (size_t)cur.pn * tstep;
    S.a_ready(cur);
    if constexpr (SP2) {
        PG8_STAGE(PG8_SB(0, 0), cB, voffB); PG8_STAGE(PG8_SB(0, 1), cB + hstep, voffB); PG8_STAGE(PG8_SA(0, 0), cA, voffA); PG8_STAGE(PG8_SA(0, 1), cA + hstep, voffA);
        if (wr == 1) PG8_BAR;
        PG8_WAIT_V(2); PG8_BAR;
        PG8_STAGE(PG8_SB(1, 0), cB + kstep, voffB); PG8_STAGE(PG8_SA(1, 0), cA + kstep, voffA); PG8_STAGE(PG8_SB(1, 1), cB + hstep + kstep, voffB);
        PG8_WAIT_V(6); PG8_BAR;
    } else {
        PG8_STAGE(PG8_SB(0, 0), cB, voffB); PG8_STAGE(PG8_SA(0, 0), cA, voffA); PG8_STAGE(PG8_SB(0, 1), cB + hstep, voffB); PG8_STAGE(PG8_SA(0, 1), cA + hstep, voffA);
        if (wr == 1) PG8_BAR;
        PG8_WAIT_V(4); PG8_BAR;
        PG8_STAGE(PG8_SB(1, 0), cB + kstep, voffB); PG8_STAGE(PG8_SA(1, 0), cA + kstep, voffA); PG8_STAGE(PG8_SB(1, 1), cB + hstep + kstep, voffB);
        PG8_WAIT_V(6); PG8_BAR;
    }
    for (;;) {
        const bool has_next = S.next(ui + 1, nxt);
        const char* nA = has_next ? (const char*)g.A + (size_t)nxt.pm * tstep : cA; const char* nB = has_next ? (const char*)g.Bt + (size_t)nxt.pn * tstep : cB;
        for (int t = 0; t < nt; t += 2) {
            const bool last = (t == nt - 2);
            const char* a1 = cA + (size_t)(t + 1) * kstep;
            const char* a2 = last ? nA : cA + (size_t)(t + 2) * kstep; const char* b2 = last ? nB : cB + (size_t)(t + 2) * kstep;
            const char* a3 = a2 + kstep; const char* b3 = b2 + kstep;
            if (last && has_next) S.a_ready(nxt);
            if constexpr (SP2) {
            PG8_LDB(B0, 0, 0); PG8_LDB(B1, 0, 1); PG8_SCHED; PG8_LDA(At, 0, 0); PG8_STAGE(PG8_SA(1, 1), a1 + hstep, voffA);
            PG8_WAIT_V(8); PG8_WAIT_L(0); PG8_BAR; PG8_MMA(0, 0, At, B0); PG8_MMA(0, 1, At, B1); PG8_BAR; PG8_SCHED;
            PG8_LDA(At, 0, 1); PG8_STAGE(PG8_SB(0, 0), b2, voffB); PG8_STAGE(PG8_SB(0, 1), b2 + hstep, voffB); PG8_STAGE(PG8_SA(0, 0), a2, voffA);
            PG8_WAIT_V(8); PG8_WAIT_L(0); PG8_BAR; PG8_MMA(1, 0, At, B0); PG8_MMA(1, 1, At, B1); PG8_BAR; PG8_SCHED;
            PG8_LDB(B0, 1, 0); PG8_LDB(B1, 1, 1); PG8_SCHED; PG8_LDA(At, 1, 0); PG8_STAGE(PG8_SA(0, 1), a2 + hstep, voffA);
            PG8_WAIT_V(8); PG8_WAIT_L(0); PG8_BAR; PG8_MMA(0, 0, At, B0); PG8_MMA(0, 1, At, B1); PG8_BAR; PG8_SCHED;
            PG8_LDA(At, 1, 1); PG8_STAGE(PG8_SB(1, 0), b3, voffB); PG8_STAGE(PG8_SB(1, 1), b3 + hstep, voffB); PG8_STAGE(PG8_SA(1, 0), a3, voffA);
            PG8_WAIT_V(8); PG8_WAIT_L(0); PG8_BAR; PG8_MMA(1, 0, At, B0); PG8_MMA(1, 1, At, B1); PG8_BAR; PG8_SCHED;
            } else {
            PG8_LDB(B0, 0, 0); PG8_SCHED; PG8_LDA(At, 0, 0); PG8_STAGE(PG8_SA(1, 1), a1 + hstep, voffA);
            PG8_WAIT_L(8); PG8_BAR; PG8_WAIT_L(0); PG8_MMA(0, 0, At, B0); PG8_BAR; PG8_SCHED;
            PG8_LDB(B1, 0, 1); PG8_STAGE(PG8_SB(0, 0), b2, voffB);
            PG8_BAR; PG8_WAIT_L(0); PG8_MMA(0, 1, At, B1); PG8_BAR;
            PG8_LDA(At, 0, 1); PG8_STAGE(PG8_SA(0, 0), a2, voffA);
            PG8_BAR; PG8_WAIT_L(0); PG8_MMA(1, 0, At, B0); PG8_BAR; PG8_SCHED;
            PG8_STAGE(PG8_SB(0, 1), b2 + hstep, voffB);
            PG8_WAIT_V(6); PG8_BAR; PG8_MMA(1, 1, At, B1); PG8_BAR;
            PG8_LDB(B0, 1, 0); PG8_SCHED; PG8_LDA(At, 1, 0); PG8_STAGE(PG8_SA(0, 1), a2 + hstep, voffA);
            PG8_WAIT_L(8); PG8_BAR; PG8_WAIT_L(0); PG8_MMA(0, 0, At, B0); PG8_BAR; PG8_SCHED;
            PG8_LDB(B1, 1, 1); PG8_STAGE(PG8_SB(1, 0), b3, voffB);
            PG8_BAR; PG8_WAIT_L(0); PG8_MMA(0, 1, At, B1); PG8_BAR;
            PG8_LDA(At, 1, 1); PG8_STAGE(PG8_SA(1, 0), a3, voffA);
            PG8_BAR; PG8_WAIT_L(0); PG8_MMA(1, 0, At, B0); PG8_BAR; PG8_SCHED;
            PG8_STAGE(PG8_SB(1, 1), b3 + hstep, voffB);
            PG8_WAIT_V(6); PG8_BAR; PG8_MMA(1, 1, At, B1); PG8_BAR;
            }
        }
        if constexpr (ALIGN_EPI) { if (wr == 0) PG8_BAR; }
        if constexpr (!Epi::AFTER_DRAIN) { E(acc, cur, wr, wc, fr, fq); S.done(cur); }
        if (!has_next) break;
#pragma unroll
        for (int a = 0; a < 2; ++a)
#pragma unroll
            for (int b = 0; b < 2; ++b)
#pragma unroll
                for (int m = 0; m < 4; ++m)
#pragma unroll
                    for (int n = 0; n < 2; ++n) acc[a][b][m][n] = (f32x4){0.f, 0.f, 0.f, 0.f};
        cur = nxt; cA = nA; cB = nB; ++ui;
        if constexpr (ALIGN_EPI) { if (wr == 1) PG8_BAR; }
    }
    PG8_WAIT_V(0);
    if constexpr (!ALIGN_EPI) { if (wr == 0) PG8_BAR; }
    PG8_BAR;
    if constexpr (Epi::AFTER_DRAIN) { E.fused(acc, cur, wr, wc, fr, fq, lds, wid, lane); S.done(cur); }
#undef PG8_SA
#undef PG8_SB
#undef PG8_STAGE
#undef PG8_LDA
#undef PG8_LDB
#undef PG8_MMA
#undef PG8_WAIT_V
#undef PG8_WAIT_L
#undef PG8_BAR
#undef PG8_SCHED
}
}

#define DI __device__ __forceinline__
#define LAS __attribute__((address_space(3)))
using pg8::bf16_t; using pg8::f32x4; using pg8::u32x4; using pg8::Unit; using pg8::cvt_pk_bf16;
typedef unsigned u32x2 __attribute__((ext_vector_type(2)));
typedef float f32x2v __attribute__((ext_vector_type(2)));

constexpr int M = 16384, D = 1024, SEQ = 4096, FF = 2816, NGU = 5632, NIN = 3872, NINP = 4096, KL = 384, NL = 1536, DP = 256;
constexpr int TR = 512, NR = SEQ / TR, REC = 384;
constexpr float ALPHA = 1.189207115002721f;
constexpr size_t MiB = (size_t)1 << 20;
constexpr size_t WS_ST = MiB / 2, WS_CS = 1 * MiB, WS_WGU = 2 * MiB, WS_WD = 13 * MiB, WS_WIN = 19 * MiB, WS_WLORA = 27 * MiB, WS_WOUT = 29 * MiB,
                 WS_WPG = 31 * MiB, WS_WPP = 33 * MiB, WS_PB = 34 * MiB, WS_XB = 42 * MiB, WS_A = 74 * MiB, WS_B = 162 * MiB, WS_SC = 226 * MiB, WS_END = 254 * MiB;
constexpr int LDS_BYTES = 136 * 1024;
constexpr size_t WS_C1WIN = 16384, WS_C2WIN = WS_C1WIN + 16384, WS_C1GU = WS_C2WIN + 16384, WS_C2GU = WS_C1GU + 24576, WS_C1PG = WS_C2GU + 24576, WS_C2PG = WS_C1PG + 4096, WS_RSTAT = 131072, WS_ZERO_BYTES = 524288;
constexpr float LN_EPS = 1e-5f;
#ifndef PG_ALIGN
#define PG_ALIGN true
#endif
#ifndef DUP_GEMM
#define DUP_GEMM 1
#endif
#ifndef DUP_RET
#define DUP_RET 1
#endif
#ifndef DUP_MISC
#define DUP_MISC 1
#endif

constexpr int NPH = 12 + (NR + 2);

DI int launder_v(int x) { asm volatile("" : "+v"(x)); return x; }
DI float bf2f(bf16_t v) { return __uint_as_float((unsigned)v << 16); }
DI bf16_t f2bf(float x) { return (bf16_t)(cvt_pk_bf16(x, 0.f) & 0xffffu); }
template <int CTRL> DI float dpp_f(float x) { return __builtin_bit_cast(float, __builtin_amdgcn_update_dpp(0, __builtin_bit_cast(int, x), CTRL, 0xf, 0xf, true)); }
DI float red16(float x) { x += dpp_f<0xB1>(x); x += dpp_f<0x4E>(x); x += dpp_f<0x141>(x); x += dpp_f<0x140>(x); return x; }
DI float sum_rows4(float x) {
    float a = x, b = x; asm("s_nop 1\n\tv_permlane16_swap_b32 %0, %1\n\ts_nop 1" : "+v"(a), "+v"(b)); x = a + b;
    a = x; b = x; asm("s_nop 1\n\tv_permlane32_swap_b32 %0, %1\n\ts_nop 1" : "+v"(a), "+v"(b)); return a + b;
}
DI float wave_sum(float v) { return sum_rows4(red16(v)); }
DI float sigmoidf_(float x) { return 1.0f / (1.0f + __expf(-x)); }
DI float silu_fast(float x) { return x * __builtin_amdgcn_rcpf(1.0f + __expf(-x)); }

DI void row_stats(const float* stat, int row, float& mu, float& rstd) {
    const f32x2v st = *(const f32x2v*)(stat + 2 * (size_t)row); mu = st.x * (1.0f / D); const float var = fmaxf(st.y * (1.0f / D) - mu * mu, 0.f); rstd = 1.0f / sqrtf(var + LN_EPS);
}
DI f32x4 ln_fix(f32x4 a, float mu, float rstd, f32x4 c1, f32x4 c2) { return (a - c1 * mu) * rstd + c2; }
struct EpiGU {
    static constexpr bool PERM = true, AFTER_DRAIN = false; bf16_t* H; const float* stat; const float* c1; const float* c2;
    DI void operator()(const f32x4 (&acc)[2][2][4][2], const Unit& u, int wr, int wc, int fr, int fq) const {
        const int row0 = u.pm * 256 + wr * 64 + fr, col0 = u.pn * 128 + wc * 32 + 8 * fq;
        f32x4 cc1[4], cc2[4];
        if (stat) { const int pc = u.pn * 256 + wc * 32 + 8 * fq;
            cc1[0] = *(const f32x4*)(c1 + pc); cc1[1] = *(const f32x4*)(c1 + pc + 4); cc1[2] = *(const f32x4*)(c1 + pc + 128); cc1[3] = *(const f32x4*)(c1 + pc + 132);
            cc2[0] = *(const f32x4*)(c2 + pc); cc2[1] = *(const f32x4*)(c2 + pc + 4); cc2[2] = *(const f32x4*)(c2 + pc + 128); cc2[3] = *(const f32x4*)(c2 + pc + 132); }
#pragma unroll
        for (int ai = 0; ai < 2; ++ai)
#pragma unroll
            for (int m = 0; m < 4; ++m) {
                bf16_t* p = H + (size_t)(row0 + ai * 128 + m * 16) * FF + col0;
                f32x4 g0 = acc[ai][0][m][0], g1 = acc[ai][0][m][1], u0 = acc[ai][1][m][0], u1 = acc[ai][1][m][1];
                if (stat) { float mu, rstd; row_stats(stat, row0 + ai * 128 + m * 16, mu, rstd);
                    g0 = ln_fix(g0, mu, rstd, cc1[0], cc2[0]); g1 = ln_fix(g1, mu, rstd, cc1[1], cc2[1]); u0 = ln_fix(u0, mu, rstd, cc1[2], cc2[2]); u1 = ln_fix(u1, mu, rstd, cc1[3], cc2[3]); }
                u32x4 w;
                w.x = cvt_pk_bf16(silu_fast(g0[0]) * u0[0], silu_fast(g0[1]) * u0[1]); w.y = cvt_pk_bf16(silu_fast(g0[2]) * u0[2], silu_fast(g0[3]) * u0[3]);
                w.z = cvt_pk_bf16(silu_fast(g1[0]) * u1[0], silu_fast(g1[1]) * u1[1]); w.w = cvt_pk_bf16(silu_fast(g1[2]) * u1[2], silu_fast(g1[3]) * u1[3]);
                *(u32x4*)p = w;
            }
    }
};
struct EpiRes {
    static constexpr bool PERM = true, AFTER_DRAIN = false; const float* Xraw; float* Yio; bf16_t* YB; float* stat_out; const float* ln_stat; const float* ln_g; const float* ln_b; float s;
    DI void operator()(const f32x4 (&acc)[2][2][4][2], const Unit& u, int wr, int wc, int fr, int fq) const {
        const int row0 = u.pm * 256 + wr * 64 + fr, col0 = u.pn * 256 + wc * 32 + 8 * fq;
        f32x4 gv[2][2], bv[2][2];
        if (ln_stat) {
#pragma unroll
            for (int bj = 0; bj < 2; ++bj) { gv[bj][0] = *(const f32x4*)(ln_g + col0 + bj * 128); gv[bj][1] = *(const f32x4*)(ln_g + col0 + bj * 128 + 4); bv[bj][0] = *(const f32x4*)(ln_b + col0 + bj * 128); bv[bj][1] = *(const f32x4*)(ln_b + col0 + bj * 128 + 4); }
        }
#pragma unroll
        for (int ai = 0; ai < 2; ++ai)
#pragma unroll
            for (int m = 0; m < 4; ++m) {
                const int row = row0 + ai * 128 + m * 16; float mu = 0.f, rstd = 1.f; if (ln_stat) row_stats(ln_stat, row, mu, rstd);
                float rs = 0.f, rq = 0.f;
#pragma unroll
                for (int bj = 0; bj < 2; ++bj) {
                    const size_t off = (size_t)row * D + col0 + bj * 128;
                    f32x4 x0, x1;
                    if (ln_stat) { x0 = *(const f32x4*)(Yio + off); x1 = *(const f32x4*)(Yio + off + 4);
                        x0 = (x0 - mu) * rstd * gv[bj][0] + bv[bj][0]; x1 = (x1 - mu) * rstd * gv[bj][1] + bv[bj][1]; }
                    else { x0 = __builtin_nontemporal_load((const f32x4*)(Xraw + off)); x1 = __builtin_nontemporal_load((const f32x4*)(Xraw + off + 4)); }
                    const f32x4 y0 = x0 * ALPHA + acc[ai][bj][m][0] * s, y1 = x1 * ALPHA + acc[ai][bj][m][1] * s;
                    *(f32x4*)(Yio + off) = y0; *(f32x4*)(Yio + off + 4) = y1;
                    u32x4 w; w.x = cvt_pk_bf16(y0[0], y0[1]); w.y = cvt_pk_bf16(y0[2], y0[3]); w.z = cvt_pk_bf16(y1[0], y1[1]); w.w = cvt_pk_bf16(y1[2], y1[3]);
                    *(u32x4*)(YB + off) = w;
                    rs += (y0[0] + y0[1]) + (y0[2] + y0[3]) + (y1[0] + y1[1]) + (y1[2] + y1[3]);
                    rq += (y0[0] * y0[0] + y0[1] * y0[1]) + (y0[2] * y0[2] + y0[3] * y0[3]) + (y1[0] * y1[0] + y1[1] * y1[1]) + (y1[2] * y1[2] + y1[3] * y1[3]);
                }
                rs = sum_rows4(rs); rq = sum_rows4(rq);
                if (fq == 0) { atomicAdd(stat_out + 2 * (size_t)row, rs); atomicAdd(stat_out + 2 * (size_t)row + 1, rq); }
            }
    }
};
struct EpiWin {
    static constexpr bool PERM = true, AFTER_DRAIN = false; bf16_t* ZRET; bf16_t* ZRW; const float* CS; const float* stat; const float* c1; const float* c2;
    DI void operator()(const f32x4 (&acc)[2][2][4][2], const Unit& u, int wr, int wc, int fr, int fq) const {
        const int row0 = u.pm * 256 + wr * 64 + fr;
        f32x4 cc1[4], cc2[4];
        { const int pc = u.pn * 256 + wc * 32 + 8 * fq;
            cc1[0] = *(const f32x4*)(c1 + pc); cc1[1] = *(const f32x4*)(c1 + pc + 4); cc1[2] = *(const f32x4*)(c1 + pc + 128); cc1[3] = *(const f32x4*)(c1 + pc + 132);
            cc2[0] = *(const f32x4*)(c2 + pc); cc2[1] = *(const f32x4*)(c2 + pc + 4); cc2[2] = *(const f32x4*)(c2 + pc + 128); cc2[3] = *(const f32x4*)(c2 + pc + 132); }
        if (u.pn < 4) {
            const int sec = u.pn >> 1, head = (u.pn & 1) * 4 + wc; const float sc = sec ? 0.125f : 1.0f;
#pragma unroll
            for (int ai = 0; ai < 2; ++ai)
#pragma unroll
                for (int m = 0; m < 4; ++m) {
                    const int row = row0 + ai * 128 + m * 16, pos = row & (SEQ - 1);
                    const f32x4* cs = (const f32x4*)(CS + ((size_t)pos * 32 + 8 * fq) * 2);
                    const f32x4 c01 = cs[0], c23 = cs[1], c45 = cs[2], c67 = cs[3];
                    float mu, rstd; row_stats(stat, row, mu, rstd);
                    const f32x4 a0 = ln_fix(acc[ai][0][m][0], mu, rstd, cc1[0], cc2[0]), a1 = ln_fix(acc[ai][0][m][1], mu, rstd, cc1[1], cc2[1]),
                                b0 = ln_fix(acc[ai][1][m][0], mu, rstd, cc1[2], cc2[2]), b1 = ln_fix(acc[ai][1][m][1], mu, rstd, cc1[3], cc2[3]);
                    u32x4 o1, o2;
                    o1.x = cvt_pk_bf16((a0[0] * c01[0] - b0[0] * c01[1]) * sc, (a0[1] * c01[2] - b0[1] * c01[3]) * sc);
                    o1.y = cvt_pk_bf16((a0[2] * c23[0] - b0[2] * c23[1]) * sc, (a0[3] * c23[2] - b0[3] * c23[3]) * sc);
                    o1.z = cvt_pk_bf16((a1[0] * c45[0] - b1[0] * c45[1]) * sc, (a1[1] * c45[2] - b1[1] * c45[3]) * sc);
                    o1.w = cvt_pk_bf16((a1[2] * c67[0] - b1[2] * c67[1]) * sc, (a1[3] * c67[2] - b1[3] * c67[3]) * sc);
                    o2.x = cvt_pk_bf16((a0[0] * c01[1] + b0[0] * c01[0]) * sc, (a0[1] * c01[3] + b0[1] * c01[2]) * sc);
                    o2.y = cvt_pk_bf16((a0[2] * c23[1] + b0[2] * c23[0]) * sc, (a0[3] * c23[3] + b0[3] * c23[2]) * sc);
                    o2.z = cvt_pk_bf16((a1[0] * c45[1] + b1[0] * c45[0]) * sc, (a1[1] * c45[3] + b1[1] * c45[2]) * sc);
                    o2.w = cvt_pk_bf16((a1[2] * c67[1] + b1[2] * c67[0]) * sc, (a1[3] * c67[3] + b1[3] * c67[2]) * sc);
                    bf16_t* p = ZRET + (size_t)row * 2048 + sec * 512 + head * 64 + 8 * fq;
                    *(u32x4*)p = o1; *(u32x4*)(p + 32) = o2;
                }
        } else {
            bf16_t* base = (u.pn < 8) ? ZRET + u.pn * 256 : ZRW + (u.pn - 8) * 256;
            const int col0 = wc * 32 + 8 * fq;
#pragma unroll
            for (int ai = 0; ai < 2; ++ai)
#pragma unroll
                for (int m = 0; m < 4; ++m)
#pragma unroll
                    for (int bj = 0; bj < 2; ++bj) {
                        float mu, rstd; row_stats(stat, row0 + ai * 128 + m * 16, mu, rstd);
                        const f32x4 v0 = ln_fix(acc[ai][bj][m][0], mu, rstd, cc1[2 * bj], cc2[2 * bj]), v1 = ln_fix(acc[ai][bj][m][1], mu, rstd, cc1[2 * bj + 1], cc2[2 * bj + 1]); u32x4 w;
                        w.x = cvt_pk_bf16(v0[0], v0[1]); w.y = cvt_pk_bf16(v0[2], v0[3]); w.z = cvt_pk_bf16(v1[0], v1[1]); w.w = cvt_pk_bf16(v1[2], v1[3]);
                        *(u32x4*)(base + (size_t)(row0 + ai * 128 + m * 16) * 2048 + col0 + bj * 128) = w;
                    }
        }
    }
};
DI float decay_from_lora(float x) { const float nx = -x; const float sp = fmaxf(nx, 0.f) + log1pf(__expf(-fabsf(nx))); return __expf(-__expf(-sp - 0.5f)); }
struct EpiLora {
    static constexpr bool PERM = true, AFTER_DRAIN = false; float* LW; bf16_t* LA2; bf16_t* LG; const float* w0; const float* a0;
    DI void operator()(const f32x4 (&acc)[2][2][4][2], const Unit& u, int wr, int wc, int fr, int fq) const {
        const int row0 = u.pm * 256 + wr * 64 + fr, kind = u.pn >> 1, cb = (u.pn & 1) * 256 + wc * 32 + 8 * fq;
        if (kind == 0) {
#pragma unroll
            for (int bj = 0; bj < 2; ++bj) {
                const f32x4 bi0 = *(const f32x4*)(w0 + cb + bj * 128), bi1 = *(const f32x4*)(w0 + cb + bj * 128 + 4);
#pragma unroll
                for (int ai = 0; ai < 2; ++ai)
#pragma unroll
                    for (int m = 0; m < 4; ++m) {
                        const size_t off = (size_t)(row0 + ai * 128 + m * 16) * 512 + cb + bj * 128;
                        const f32x4 v0 = acc[ai][bj][m][0] + bi0, v1 = acc[ai][bj][m][1] + bi1; f32x4 o0, o1;
                        o0 = v0; o1 = v1;
                        *(f32x4*)(LW + off) = o0; *(f32x4*)(LW + off + 4) = o1;
                    }
            }
        } else if (kind == 1) {
#pragma unroll
            for (int bj = 0; bj < 2; ++bj) {
                const f32x4 bi0 = *(const f32x4*)(a0 + cb + bj * 128), bi1 = *(const f32x4*)(a0 + cb + bj * 128 + 4);
#pragma unroll
                for (int ai = 0; ai < 2; ++ai)
#pragma unroll
                    for (int m = 0; m < 4; ++m) {
                        const size_t off = (size_t)(row0 + ai * 128 + m * 16) * 512 + cb + bj * 128;
                        const f32x4 v0 = acc[ai][bj][m][0] + bi0, v1 = acc[ai][bj][m][1] + bi1; u32x4 w;
                        w.x = cvt_pk_bf16(v0[0], v0[1]); w.y = cvt_pk_bf16(v0[2], v0[3]); w.z = cvt_pk_bf16(v1[0], v1[1]); w.w = cvt_pk_bf16(v1[2], v1[3]);
                        *(u32x4*)(LA2 + off) = w;
                    }
            }
        } else {
#pragma unroll
            for (int bj = 0; bj < 2; ++bj)
#pragma unroll
                for (int ai = 0; ai < 2; ++ai)
#pragma unroll
                    for (int m = 0; m < 4; ++m) {
                        const size_t off = (size_t)(row0 + ai * 128 + m * 16) * 512 + cb + bj * 128;
                        const f32x4 v0 = acc[ai][bj][m][0], v1 = acc[ai][bj][m][1]; u32x4 w;
                        w.x = cvt_pk_bf16(v0[0], v0[1]); w.y = cvt_pk_bf16(v0[2], v0[3]); w.z = cvt_pk_bf16(v1[0], v1[1]); w.w = cvt_pk_bf16(v1[2], v1[3]);
                        *(u32x4*)(LG + off) = w;
                    }
        }
    }
};
struct EpiProj {
    static constexpr bool PERM = true, AFTER_DRAIN = false; bf16_t* P;
    DI void operator()(const f32x4 (&acc)[2][2][4][2], const Unit& u, int wr, int wc, int fr, int fq) const {
        const int row0 = u.pm * 256 + wr * 64 + fr, col0 = u.pn * 256 + wc * 32 + 8 * fq;
#pragma unroll
        for (int ai = 0; ai < 2; ++ai)
#pragma unroll
            for (int m = 0; m < 4; ++m)
#pragma unroll
                for (int bj = 0; bj < 2; ++bj) {
                    const size_t off = (size_t)(row0 + ai * 128 + m * 16) * D + col0 + bj * 128;
                    const f32x4 v0 = acc[ai][bj][m][0], v1 = acc[ai][bj][m][1]; u32x4 w;
                    w.x = cvt_pk_bf16(v0[0], v0[1]); w.y = cvt_pk_bf16(v0[2], v0[3]); w.z = cvt_pk_bf16(v1[0], v1[1]); w.w = cvt_pk_bf16(v1[2], v1[3]);
                    *(u32x4*)(P + off) = w;
                }
    }
};
struct EpiGate {
    static constexpr bool PERM = true, AFTER_DRAIN = false; float* XO; const bf16_t* P; const float* bias; const float* stat; const float* c1; const float* c2; const float* ln_g; const float* ln_b;
    DI void operator()(const f32x4 (&acc)[2][2][4][2], const Unit& u, int wr, int wc, int fr, int fq) const {
        const int row0 = u.pm * 256 + wr * 64 + fr, col0 = u.pn * 256 + wc * 32 + 8 * fq;
#pragma unroll
        for (int ai = 0; ai < 2; ++ai)
#pragma unroll
            for (int m = 0; m < 4; ++m) {
                const int row = row0 + ai * 128 + m * 16; float mu, rstd; row_stats(stat, row, mu, rstd);
#pragma unroll
                for (int bj = 0; bj < 2; ++bj) {
                    const int col = col0 + bj * 128; const size_t off = (size_t)row * D + col;
                    const f32x4 bb0 = *(const f32x4*)(bias + col), bb1 = *(const f32x4*)(bias + col + 4);
                    const f32x4 g0 = ln_fix(acc[ai][bj][m][0], mu, rstd, *(const f32x4*)(c1 + col), *(const f32x4*)(c2 + col)) + bb0, g1 = ln_fix(acc[ai][bj][m][1], mu, rstd, *(const f32x4*)(c1 + col + 4), *(const f32x4*)(c2 + col + 4)) + bb1;
                    f32x4 x0 = *(const f32x4*)(XO + off), x1 = *(const f32x4*)(XO + off + 4); const u32x4 pw = __builtin_nontemporal_load((const u32x4*)(P + off));
                    const f32x4 p0 = (f32x4){__uint_as_float(pw.x << 16), __uint_as_float(pw.x & 0xffff0000u), __uint_as_float(pw.y << 16), __uint_as_float(pw.y & 0xffff0000u)},
                                p1 = (f32x4){__uint_as_float(pw.z << 16), __uint_as_float(pw.z & 0xffff0000u), __uint_as_float(pw.w << 16), __uint_as_float(pw.w & 0xffff0000u)};
                    x0 = (x0 - mu) * rstd * *(const f32x4*)(ln_g + col) + *(const f32x4*)(ln_b + col); x1 = (x1 - mu) * rstd * *(const f32x4*)(ln_g + col + 4) + *(const f32x4*)(ln_b + col + 4);
                    f32x4 o0, o1;
#pragma unroll
                    for (int e = 0; e < 4; ++e) { o0[e] = x0[e] + sigmoidf_(g0[e]) * p0[e]; o1[e] = x1[e] + sigmoidf_(g1[e]) * p1[e]; }
                    *(f32x4*)(XO + off) = o0; *(f32x4*)(XO + off + 4) = o1;
                }
            }
    }
};

struct Ctx { int tid, lane, wave, bx, G, gw, NGW, gtid, NGT; LAS unsigned char* lds; };

DI void transpose_item(const float* __restrict__ W, int N, bf16_t* __restrict__ WT, int K, int dst_row0, int k0, int n0, LAS float* scr, int lane,
                       const float* lng = nullptr, const float* lnb = nullptr, float* c1 = nullptr, float* c2 = nullptr) {
    const int kr = lane >> 3, nq = (lane & 7) * 4;
    f32x4 v[8];
#pragma unroll
    for (int i = 0; i < 8; ++i) v[i] = __builtin_nontemporal_load((const f32x4*)(W + (size_t)(k0 + kr + 8 * i) * N + n0 + nq));
    if (lng) {
        f32x4 cp = (f32x4){0.f, 0.f, 0.f, 0.f};
#pragma unroll
        for (int i = 0; i < 8; ++i) { cp = cp + v[i] * lnb[k0 + kr + 8 * i]; v[i] = v[i] * lng[k0 + kr + 8 * i]; }
#pragma unroll
        for (int j = 0; j < 4; ++j) { float t = cp[j]; t += __shfl_xor(t, 8); t += __shfl_xor(t, 16); t += __shfl_xor(t, 32); cp[j] = t; }
        if (lane < 8) {
#pragma unroll
            for (int j = 0; j < 4; ++j) atomicAdd(c2 + dst_row0 + nq + j, cp[j]);
        }
    }
#pragma unroll
    for (int i = 0; i < 8; ++i) { LAS float* d = scr + (kr + 8 * i) * 33 + nq; d[0] = v[i][0]; d[1] = v[i][1]; d[2] = v[i][2]; d[3] = v[i][3]; }
    asm volatile("s_waitcnt lgkmcnt(0)" ::: "memory");
    const int c = lane & 7;
#pragma unroll
    for (int j = 0; j < 4; ++j) { const int n = (lane >> 3) + 8 * j; const LAS float* s = scr + (8 * c) * 33 + n;
        u32x4 o; o.x = cvt_pk_bf16(s[0], s[33]); o.y = cvt_pk_bf16(s[66], s[99]); o.z = cvt_pk_bf16(s[132], s[165]); o.w = cvt_pk_bf16(s[198], s[231]);
        *(u32x4*)(WT + (size_t)(dst_row0 + n) * K + k0 + 8 * c) = o;
        if (lng) {
            float t = 0.f;
#pragma unroll
            for (int e = 0; e < 4; ++e) t += __uint_as_float(o[e] << 16) + __uint_as_float(o[e] & 0xffff0000u);
            t += __shfl_xor(t, 1); t += __shfl_xor(t, 2); t += __shfl_xor(t, 4);
            if (c == 0) atomicAdd(c1 + dst_row0 + n, t);
        } }
    asm volatile("s_waitcnt lgkmcnt(0)" ::: "memory");
}
DI int gu_dst_row(int c0) { const int isup = c0 >= FF; const int c = isup ? c0 - FF : c0; return 256 * (c >> 7) + 128 * isup + (c & 127); }
DI int win_dst_row(int c0) {
    if (c0 < 1024) { const int sec = c0 >> 9, hh = (c0 & 511) >> 6, half = (c0 & 63) >> 5; return 256 * (sec * 2 + (hh >> 2)) + 128 * half + 32 * (hh & 3); }
    return c0;
}
DI void cvt_rows_bf16(const Ctx& c, const float* src, bf16_t* dst, size_t n4) {
    for (size_t i = c.gtid; i < n4; i += c.NGT) { const f32x4 v = __builtin_nontemporal_load((const f32x4*)src + i); u32x2 o; o.x = cvt_pk_bf16(v[0], v[1]); o.y = cvt_pk_bf16(v[2], v[3]); ((u32x2*)dst)[i] = o; }
}
DI void convert_ffn(const Ctx& c, const float* wgu, const float* wd, bf16_t* Wgu_t, bf16_t* Wd_t, const float* lng = nullptr, const float* lnb = nullptr, float* c1 = nullptr, float* c2 = nullptr) {
    LAS float* scr = (LAS float*)(c.lds + c.wave * 8448);
    for (int it = c.gw; it < 2816 + 1408; it += c.NGW) {
        if (it < 2816) { const int kb = it / 176, nb = it % 176; transpose_item(wgu, NGU, Wgu_t, D, gu_dst_row(32 * nb), 64 * kb, 32 * nb, scr, c.lane, lng, lnb, c1, c2); }
        else { const int r = it - 2816, kb = r / 32, nb = r % 32; transpose_item(wd, D, Wd_t, FF, 32 * nb, 64 * kb, 32 * nb, scr, c.lane); }
    }
}
DI void layer_norm_rows(const Ctx& c, const float* Y, const float* g, const float* b, float* XF, bf16_t* XB) {
    const f32x4 g0 = ((const f32x4*)g)[c.lane], g1 = ((const f32x4*)g)[c.lane + 64], g2 = ((const f32x4*)g)[c.lane + 128], g3 = ((const f32x4*)g)[c.lane + 192];
    const f32x4 b0 = ((const f32x4*)b)[c.lane], b1 = ((const f32x4*)b)[c.lane + 64], b2 = ((const f32x4*)b)[c.lane + 128], b3 = ((const f32x4*)b)[c.lane + 192];
    for (int m = c.gw; m < M; m += c.NGW) {
        const f32x4* yr = (const f32x4*)(Y + (size_t)m * D) + c.lane;
        f32x4 v0 = yr[0], v1 = yr[64], v2 = yr[128], v3 = yr[192];
        float s = (v0[0] + v0[1] + v0[2] + v0[3]) + (v1[0] + v1[1] + v1[2] + v1[3]) + (v2[0] + v2[1] + v2[2] + v2[3]) + (v3[0] + v3[1] + v3[2] + v3[3]);
        const float mean = wave_sum(s) * (1.0f / D);
        v0 = v0 - mean; v1 = v1 - mean; v2 = v2 - mean; v3 = v3 - mean;
        float q = (v0[0] * v0[0] + v0[1] * v0[1] + v0[2] * v0[2] + v0[3] * v0[3]) + (v1[0] * v1[0] + v1[1] * v1[1] + v1[2] * v1[2] + v1[3] * v1[3])
                + (v2[0] * v2[0] + v2[1] * v2[1] + v2[2] * v2[2] + v2[3] * v2[3]) + (v3[0] * v3[0] + v3[1] * v3[1] + v3[2] * v3[2] + v3[3] * v3[3]);
        const float rstd = 1.0f / sqrtf(wave_sum(q) * (1.0f / D) + 1e-5f);
        v0 = v0 * rstd * g0 + b0; v1 = v1 * rstd * g1 + b1; v2 = v2 * rstd * g2 + b2; v3 = v3 * rstd * g3 + b3;
        f32x4* xo = (f32x4*)(XF + (size_t)m * D) + c.lane; xo[0] = v0; xo[64] = v1; xo[128] = v2; xo[192] = v3;
        u32x2* bo = (u32x2*)(XB + (size_t)m * D) + c.lane; u32x2 o;
        o.x = cvt_pk_bf16(v0[0], v0[1]); o.y = cvt_pk_bf16(v0[2], v0[3]); bo[0] = o;
        o.x = cvt_pk_bf16(v1[0], v1[1]); o.y = cvt_pk_bf16(v1[2], v1[3]); bo[64] = o;
        o.x = cvt_pk_bf16(v2[0], v2[1]); o.y = cvt_pk_bf16(v2[2], v2[3]); bo[128] = o;
        o.x = cvt_pk_bf16(v3[0], v3[1]); o.y = cvt_pk_bf16(v3[2], v3[3]); bo[192] = o;
    }
}
DI float zshift(const bf16_t* ZRW, size_t t, int tin, int col, const float* mu) {
    const float z = bf2f(ZRW[t * 2048 + col]); const float zp = tin ? bf2f(ZRW[(t - 1) * 2048 + col]) : 0.f;
    return z + (zp - z) * mu[col];
}
DI void prep_lora_a(const Ctx& c, const bf16_t* ZRW, const float* mu, bf16_t* LA) {
    for (int i = c.gtid; i < M * (KL / 8); i += c.NGT) {
        const int t = i / (KL / 8), g = i % (KL / 8); u32x4 o = (u32x4){0u, 0u, 0u, 0u};
        if (g < 36) {
            const int col = 1536 + 8 * g;
            const u32x4 zc = *(const u32x4*)(ZRW + (size_t)t * 2048 + col); u32x4 zp = (u32x4){0u, 0u, 0u, 0u};
            if (t & (SEQ - 1)) zp = *(const u32x4*)(ZRW + (size_t)(t - 1) * 2048 + col);
            const f32x4 m0 = *(const f32x4*)(mu + col), m1 = *(const f32x4*)(mu + col + 4);
            float r[8];
#pragma unroll
            for (int e = 0; e < 8; ++e) {
                const unsigned zw = zc[e >> 1], pw = zp[e >> 1];
                const float z = (e & 1) ? __uint_as_float(zw & 0xffff0000u) : __uint_as_float(zw << 16), pz = (e & 1) ? __uint_as_float(pw & 0xffff0000u) : __uint_as_float(pw << 16);
                const float m = e < 4 ? m0[e & 3] : m1[e & 3]; const float s = z + (pz - z) * m;
                r[e] = g < 8 ? 1.0f - 2.0f / (1.0f + __expf(2.0f * s)) : (g < 16 ? s : sigmoidf_(s));
            }
            o.x = cvt_pk_bf16(r[0], r[1]); o.y = cvt_pk_bf16(r[2], r[3]); o.z = cvt_pk_bf16(r[4], r[5]); o.w = cvt_pk_bf16(r[6], r[7]);
        }
        *(u32x4*)(LA + (size_t)t * KL + 8 * g) = o;
    }
}
DI float ret_lg2(int h) { return log1pf(-exp2f(-5.0f - (float)h)) * 1.4426950408889634f; }
DI void ret_kv(const Ctx& c, const bf16_t* ZRET, float* KV) {
    typedef pg8::bf16x8 bf16x8;
    const int w = c.wave, lane = c.lane, fr = lane & 15, fq = lane >> 4, dt = w >> 1, et0 = (w & 1) * 2;
    LAS unsigned char* L = c.lds;
    constexpr int OKT = 0, OVT = 17408;
    for (int u = c.bx; u < 1024; u += c.G) {
        const int bh = u >> 5, n = u & 31, b = bh >> 3, h = bh & 7; const float lg2 = ret_lg2(h);
        const bf16_t* zb = ZRET + ((size_t)b * SEQ + n * 128) * 2048 + h * 64;
#pragma unroll
        for (int x = 0; x < 2; ++x) {
            const int g = c.tid + 512 * x, j = g >> 3, dg = (g & 7) * 8; const bf16_t* p = zb + (size_t)j * 2048 + dg;
            const u32x4 rk = *(const u32x4*)(p + 512), rv = *(const u32x4*)(p + 1024);
            const float dj = exp2f((float)(127 - j) * lg2);
#pragma unroll
            for (int i = 0; i < 8; ++i) {
                const unsigned kw = (rk[i >> 1] >> (16 * (i & 1))) & 0xffffu, vw = (rv[i >> 1] >> (16 * (i & 1))) & 0xffffu;
                *(LAS bf16_t*)(L + OKT + (dg + i) * 272 + j * 2) = f2bf(bf2f((bf16_t)kw) * dj);
                *(LAS bf16_t*)(L + OVT + (dg + i) * 272 + j * 2) = (bf16_t)vw;
            }
        }
        __syncthreads();
        f32x4 sacc[2]; sacc[0] = (f32x4){0.f, 0.f, 0.f, 0.f}; sacc[1] = sacc[0];
#pragma unroll
        for (int ks = 0; ks < 4; ++ks) { const bf16x8 ka = *(const LAS bf16x8*)(L + OKT + (16 * dt + fr) * 272 + (ks * 32 + fq * 8) * 2);
#pragma unroll
            for (int x = 0; x < 2; ++x) { const bf16x8 vb = *(const LAS bf16x8*)(L + OVT + (16 * (et0 + x) + fr) * 272 + (ks * 32 + fq * 8) * 2); sacc[x] = __builtin_amdgcn_mfma_f32_16x16x32_bf16(ka, vb, sacc[x], 0, 0, 0); } }
        float* kvo = KV + (size_t)u * 4096;
#pragma unroll
        for (int x = 0; x < 2; ++x) *(f32x4*)(kvo + (16 * (et0 + x) + fr) * 64 + 16 * dt + fq * 4) = sacc[x];
        __syncthreads();
    }
}
DI void ret_prefix(const Ctx& c, const float* KV, bf16_t* PS) {
    for (int idx = c.gtid; idx < 32 * 4096; idx += c.NGT) {
        const int bh = idx >> 12, e = (idx >> 6) & 63, d = idx & 63; const float cdec = exp2f(128.0f * ret_lg2(bh & 7));
        float st = 0.f;
        float kv[8];
        for (int n0 = 0; n0 < 32; n0 += 8) {
#pragma unroll
            for (int j = 0; j < 8; ++j) kv[j] = KV[(size_t)(bh * 32 + n0 + j) * 4096 + e * 64 + d];
#pragma unroll
            for (int j = 0; j < 8; ++j) { PS[(size_t)(bh * 32 + n0 + j) * 4096 + e * 64 + d] = f2bf(st); st = st * cdec + kv[j]; }
        }
    }
}
DI void ret_out(const Ctx& c, const bf16_t* ZRET, const bf16_t* PS, const float* gn_g, const float* gn_b, bf16_t* MIX) {
    typedef pg8::bf16x8 bf16x8;
    const int w = c.wave, lane = c.lane, fr = lane & 15, fq = lane >> 4, i0 = 16 * w;
    LAS unsigned char* L = c.lds;
    constexpr int OQ = 0, OKS = 18432, OVT = 36864, OP = 54272;
    LAS unsigned char* Pw = L + OP + w * 4352;
    u32x4 rq[2], rk[2], rv[2], rg[2];
    constexpr int OG = 89088;
#define RET_LOAD(u_) do { const int bh_ = (u_) >> 5, n_ = (u_) & 31; const bf16_t* zb_ = ZRET + ((size_t)(bh_ >> 3) * SEQ + n_ * 128) * 2048 + (bh_ & 7) * 64; \
        _Pragma("unroll") for (int x = 0; x < 2; ++x) { const int g = c.tid + 512 * x, j = g >> 3, dg = (g & 7) * 8; const bf16_t* p = zb_ + (size_t)j * 2048 + dg; \
        rq[x] = *(const u32x4*)p; rk[x] = *(const u32x4*)(p + 512); rv[x] = *(const u32x4*)(p + 1024); rg[x] = *(const u32x4*)(p + 1536); } } while (0)
    if (c.bx < 1024) RET_LOAD(c.bx);
    for (int u = c.bx; u < 1024; u += c.G) {
        const int bh = u >> 5, n = u & 31, b = bh >> 3, h = bh & 7; const float lg2 = ret_lg2(h);
#pragma unroll
        for (int x = 0; x < 2; ++x) {
            const int g = c.tid + 512 * x, j = g >> 3, dg = (g & 7) * 8;
            *(LAS u32x4*)(L + OQ + j * 144 + dg * 2) = rq[x]; *(LAS u32x4*)(L + OKS + j * 144 + dg * 2) = rk[x]; *(LAS u32x4*)(L + OG + j * 144 + dg * 2) = rg[x];
#pragma unroll
            for (int i = 0; i < 8; ++i) *(LAS bf16_t*)(L + OVT + (dg + i) * 272 + j * 2) = (bf16_t)((rv[x][i >> 1] >> (16 * (i & 1))) & 0xffffu);
        }
        if (u + c.G < 1024) RET_LOAD(u + c.G);
        const size_t t0 = (size_t)b * SEQ + n * 128 + i0 + fq * 4;
        bf16x8 sb[2][4];
#pragma unroll
        for (int ks = 0; ks < 2; ++ks)
#pragma unroll
            for (int et = 0; et < 4; ++et) sb[ks][et] = *(const bf16x8*)(PS + (size_t)u * 4096 + (16 * et + fr) * 64 + ks * 32 + fq * 8);
        float gg[4], gb[4];
#pragma unroll
        for (int et = 0; et < 4; ++et) { gg[et] = gn_g[h * 64 + 16 * et + fr]; gb[et] = gn_b[h * 64 + 16 * et + fr]; }
        __syncthreads();
        bf16x8 qa[2];
#pragma unroll
        for (int ks = 0; ks < 2; ++ks) qa[ks] = *(const LAS bf16x8*)(L + OQ + (i0 + fr) * 144 + (ks * 32 + fq * 8) * 2);
#pragma unroll
        for (int jt = 0; jt < 8; ++jt) {
            f32x4 sc = (f32x4){0.f, 0.f, 0.f, 0.f};
#pragma unroll
            for (int ks = 0; ks < 2; ++ks) { const bf16x8 kb = *(const LAS bf16x8*)(L + OKS + (16 * jt + fr) * 144 + (ks * 32 + fq * 8) * 2); sc = __builtin_amdgcn_mfma_f32_16x16x32_bf16(qa[ks], kb, sc, 0, 0, 0); }
#pragma unroll
            for (int r = 0; r < 4; ++r) { const int di = (i0 + fq * 4 + r) - (16 * jt + fr); const float pv = di >= 0 ? sc[r] * exp2f((float)di * lg2) : 0.f;
                *(LAS bf16_t*)(Pw + (fq * 4 + r) * 272 + (16 * jt + fr) * 2) = f2bf(pv); }
        }
        f32x4 o[4], cr[4];
#pragma unroll
        for (int et = 0; et < 4; ++et) { o[et] = (f32x4){0.f, 0.f, 0.f, 0.f}; cr[et] = o[et]; }
#pragma unroll
        for (int ks = 0; ks < 4; ++ks) { const bf16x8 pa = *(const LAS bf16x8*)(Pw + fr * 272 + (ks * 32 + fq * 8) * 2);
#pragma unroll
            for (int et = 0; et < 4; ++et) { const bf16x8 vb = *(const LAS bf16x8*)(L + OVT + (16 * et + fr) * 272 + (ks * 32 + fq * 8) * 2); o[et] = __builtin_amdgcn_mfma_f32_16x16x32_bf16(pa, vb, o[et], 0, 0, 0); } }
#pragma unroll
        for (int ks = 0; ks < 2; ++ks)
#pragma unroll
            for (int et = 0; et < 4; ++et) cr[et] = __builtin_amdgcn_mfma_f32_16x16x32_bf16(qa[ks], sb[ks][et], cr[et], 0, 0, 0);
#pragma unroll
        for (int r = 0; r < 4; ++r) {
            const int i = i0 + fq * 4 + r; const float qd = exp2f((float)(i + 1) * lg2);
            float v[4]; float s = 0.f;
#pragma unroll
            for (int et = 0; et < 4; ++et) { v[et] = o[et][r] + cr[et][r] * qd; s += v[et]; }
            const float mean = red16(s) * (1.0f / 64.0f); float q = 0.f;
#pragma unroll
            for (int et = 0; et < 4; ++et) { v[et] -= mean; q += v[et] * v[et]; }
            const float rstd = 1.0f / sqrtf(red16(q) * (1.0f / 64.0f) + 1e-5f);
#pragma unroll
            for (int et = 0; et < 4; ++et) { const float g = bf2f(*(const LAS bf16_t*)(L + OG + i * 144 + (16 * et + fr) * 2));
                *(LAS bf16_t*)(L + OQ + i * 144 + (16 * et + fr) * 2) = f2bf(g * sigmoidf_(g) * (v[et] * rstd * gg[et] + gb[et])); }
        }
        asm volatile("s_waitcnt lgkmcnt(0)" ::: "memory");
#pragma unroll
        for (int x = 0; x < 2; ++x) { const int rr = lane >> 2, ch = (lane & 3) * 2 + x;
            const u32x4 ov = *(const LAS u32x4*)(L + OQ + (i0 + rr) * 144 + ch * 16);
            *(u32x4*)(MIX + ((size_t)b * SEQ + n * 128 + i0 + rr) * D + h * 64 + ch * 8) = ov; }
        __syncthreads();
    }
#undef RET_LOAD
}
struct SideP { const bf16_t* ZRW; const float* LW; const bf16_t* LA2; const bf16_t* LG; const float* mu; const float* k_k; const float* k_a; const float* r_k; const float* gn_g; const float* gn_b; bf16_t* MIX; };
DI void rounds_side(int bh, int tl_first, int tstep, int lane, int p, const SideP& P, float* SC, const float* YB) {
    const int b = bh >> 3, h = bh & 7, hc = h * 64 + lane;
    const float mu_r = P.mu[hc], mu_k = P.mu[512 + hc], mu_v = P.mu[1024 + hc], kkc = P.k_k[hc], kac = P.k_a[hc], rkc = P.r_k[hc], gg = P.gn_g[hc], gb = P.gn_b[hc];
    const bool do_post = p >= 2, do_prep = p < NR;
    for (int tl0 = tl_first; tl0 < TR; tl0 += 4 * tstep) {
        float pr[4], pk[4], pv[4], py[4], pg[4];
        float z0[4], z1[4], z2[4], q0[4], q1[4], q2[4], lw[4], la[4];
        if (do_post) {
#pragma unroll
            for (int j = 0; j < 4; ++j) { const int tl = tl0 + tstep * j; if (tl >= TR) continue; const size_t t = (size_t)b * SEQ + (p - 2) * TR + tl; const float* rec = SC + ((size_t)bh * TR + tl) * REC + lane;
                pr[j] = rec[0]; pk[j] = rec[128]; pv[j] = rec[320]; py[j] = YB[((size_t)bh * TR + tl) * 64 + lane]; pg[j] = bf2f(P.LG[t * 512 + hc]); }
        }
        if (do_prep) {
#pragma unroll
            for (int j = 0; j < 4; ++j) { if (tl0 + tstep * j >= TR) continue; const int tin = p * TR + tl0 + tstep * j; const size_t t = (size_t)b * SEQ + tin; const bf16_t* zr = P.ZRW + t * 2048 + hc;
                z0[j] = bf2f(zr[0]); z1[j] = bf2f(zr[512]); z2[j] = bf2f(zr[1024]);
                if (tin) { q0[j] = bf2f(zr[-2048]); q1[j] = bf2f(zr[512 - 2048]); q2[j] = bf2f(zr[1024 - 2048]); } else { q0[j] = 0.f; q1[j] = 0.f; q2[j] = 0.f; }
                lw[j] = P.LW[t * 512 + hc]; la[j] = bf2f(P.LA2[t * 512 + hc]); }
        }
        if (do_post) {
#pragma unroll
            for (int j = 0; j < 4; ++j) { const int tl = tl0 + tstep * j; if (tl >= TR) continue; const size_t t = (size_t)b * SEQ + (p - 2) * TR + tl;
                const float mean = wave_sum(py[j]) * (1.0f / 64.0f); const float dv = py[j] - mean; const float var = wave_sum(dv * dv) * (1.0f / 64.0f);
                const float yn = dv * (1.0f / sqrtf(var + 64e-5f)) * gg + gb; const float bonus = wave_sum(pr[j] * pk[j] * rkc) * pv[j];
                P.MIX[t * D + 512 + hc] = f2bf((yn + bonus) * pg[j]); }
        }
        if (do_prep) {
#pragma unroll
            for (int j = 0; j < 4; ++j) { const int tl = tl0 + tstep * j; if (tl >= TR) continue;
                const float r = z0[j] + (q0[j] - z0[j]) * mu_r, kr = z1[j] + (q1[j] - z1[j]) * mu_k, v = z2[j] + (q2[j] - z2[j]) * mu_v;
                const float w = decay_from_lora(lw[j]), a = sigmoidf_(la[j]);
                float kk = kr * kkc; const float n2 = wave_sum(kk * kk); kk = kk / fmaxf(sqrtf(n2), 1e-12f);
                float* rec = SC + ((size_t)bh * TR + tl) * REC + lane;
                rec[0] = r; rec[64] = w; rec[128] = kr * (1.0f + (a - 1.0f) * kac); rec[192] = kk; rec[256] = -(kk * a); rec[320] = v; }
        }
    }
}
struct StepIn { f32x4 r, w, k, kk, b; float v; };
DI float fma_(float a, float b, float c) { float d; asm("v_fma_f32 %0, %1, %2, %3" : "=v"(d) : "v"(a), "v"(b), "v"(c)); return d; }
DI float nfma_(float a, float b, float c) { float d; asm("v_fma_f32 %0, -%1, %2, %3" : "=v"(d) : "v"(a), "v"(b), "v"(c)); return d; }
DI float mul_(float a, float b) { float d; asm("v_mul_f32 %0, %1, %2" : "=v"(d) : "v"(a), "v"(b)); return d; }
#define RING_NB 4
DI unsigned lds_ld(volatile LAS unsigned* p) { return __hip_atomic_load((LAS unsigned*)p, __ATOMIC_RELAXED, __HIP_MEMORY_SCOPE_WORKGROUP); }
DI void lds_st(volatile LAS unsigned* p, unsigned v) { __hip_atomic_store((LAS unsigned*)p, v, __ATOMIC_RELAXED, __HIP_MEMORY_SCOPE_WORKGROUP); }
DI int scan_bh(int bx) { return (bx & 7) * 4 + (bx >> 6); }
DI void scan_loader(const Ctx& c, int round, const float* SC, volatile LAS unsigned* ctl) {
    const float* rec0 = SC + (size_t)scan_bh(c.bx) * TR * REC;
    const unsigned gb0 = (unsigned)round * (TR / 16);
    for (int blk = 0; blk < TR / 16; ++blk) {
        const unsigned gb = gb0 + blk;
        if (gb >= RING_NB) { while (min(lds_ld(ctl + 1), lds_ld(ctl + 2)) + RING_NB <= gb) __builtin_amdgcn_s_sleep(1); }
        asm volatile("" ::: "memory");
        LAS unsigned char* dst = c.lds + (gb % RING_NB) * 24576;
#pragma unroll
        for (int q = 0; q < 24; ++q)
            __builtin_amdgcn_global_load_lds((const unsigned*)(rec0 + (size_t)blk * 16 * REC + (q * 64 + c.lane) * 4), (LAS unsigned*)(dst + q * 1024), 16, 0, 0);
        if (blk > 0) { asm volatile("s_waitcnt vmcnt(24)" ::: "memory"); lds_st(ctl, gb); }
    }
    asm volatile("s_waitcnt vmcnt(0)" ::: "memory"); lds_st(ctl, gb0 + TR / 16);
}
DI void scan_round(const Ctx& c, int sw, int round, float* YB, float* ST, volatile LAS unsigned* ctl, bool keep = true) {
    const int bh = scan_bh(c.bx), rg = ((c.bx >> 3) & 7) * 2 + sw, kq = c.lane & 15, row = rg * 4 + (c.lane >> 4);
    float* y0 = YB + (size_t)bh * TR * 64;
    float* stp = ST + ((size_t)bh * 64 + row) * 64 + kq * 4;
    f32x4 S = (f32x4){0.f, 0.f, 0.f, 0.f};
    if (round) S = *(const f32x4*)stp;
    const unsigned gb0 = (unsigned)round * (TR / 16);
#define SCAN_LD(dst, s) do { const LAS unsigned char* ps_ = p + (s) * 1536; dst.r = *(const LAS f32x4*)(ps_ + kq * 16); dst.w = *(const LAS f32x4*)(ps_ + 256 + kq * 16); dst.k = *(const LAS f32x4*)(ps_ + 512 + kq * 16); \
        dst.kk = *(const LAS f32x4*)(ps_ + 768 + kq * 16); dst.b = *(const LAS f32x4*)(ps_ + 1024 + kq * 16); dst.v = *(const LAS float*)(ps_ + 1280 + row * 4); } while (0)
    unsigned seen = lds_ld(ctl);
    for (int blk = 0; blk < TR / 16; ++blk) {
        const unsigned gb = gb0 + blk;
        while (seen <= gb) { __builtin_amdgcn_s_sleep(1); seen = lds_ld(ctl); }
        asm volatile("" ::: "memory");
        const LAS unsigned char* p = c.lds + (gb % RING_NB) * 24576;
        float yp[16];
        StepIn cur, nxt, nx2; SCAN_LD(cur, 0); SCAN_LD(nxt, 1);
        f32x4 rprev = cur.r;
#pragma unroll
        for (int s = 0; s < 16; ++s) {
            if (s < 14) SCAN_LD(nx2, s + 2);
            if (s == 8) seen = lds_ld(ctl);
            float sa; { float a0 = mul_(S[0], cur.kk[0]), a1 = mul_(S[2], cur.kk[2]); a0 = fma_(S[1], cur.kk[1], a0); a1 = fma_(S[3], cur.kk[3], a1); asm("v_add_f32 %0, %1, %2" : "=v"(sa) : "v"(a0), "v"(a1)); }
            if (s > 0) { float y = S[0] * rprev[0]; y = fmaf(S[1], rprev[1], y); y = fmaf(S[2], rprev[2], y); y = fmaf(S[3], rprev[3], y); yp[s - 1] = y; }
            const f32x4 T = S * cur.w + cur.k * cur.v;
            sa = red16(sa);
            S = T + cur.b * sa;
            rprev = cur.r;
            if (s < 15) cur = nxt;
            if (s < 14) nxt = nx2;
        }
        { float y = S[0] * rprev[0]; y = fmaf(S[1], rprev[1], y); y = fmaf(S[2], rprev[2], y); y = fmaf(S[3], rprev[3], y); yp[15] = y; }
        float yk;
        {
            const bool b3 = (kq & 8) != 0, b2 = (kq & 4) != 0, b1 = (kq & 2) != 0, b0 = (kq & 1) != 0;
            float q8[8], q4[4], q2[2];
#pragma unroll
            for (int j = 0; j < 8; ++j) { const float keep = b3 ? yp[j + 8] : yp[j], send = b3 ? yp[j] : yp[j + 8]; q8[j] = keep + dpp_f<0x128>(send); }
#pragma unroll
            for (int j = 0; j < 4; ++j) { const float keep = b2 ? q8[j + 4] : q8[j], send = b2 ? q8[j] : q8[j + 4]; q4[j] = keep + dpp_f<0x141>(send); }
#pragma unroll
            for (int j = 0; j < 2; ++j) { const float keep = b1 ? q4[j + 2] : q4[j], send = b1 ? q4[j] : q4[j + 2]; q2[j] = keep + dpp_f<0x4E>(send); }
            { const float keep = b0 ? q2[1] : q2[0], send = b0 ? q2[0] : q2[1]; yk = keep + dpp_f<0xB1>(send); }
        }
        asm volatile("s_waitcnt lgkmcnt(0)" ::: "memory");
        lds_st(ctl + 1 + sw, gb + 1);
        y0[(size_t)(blk * 16 + kq) * 64 + row] = yk;
    }
#undef SCAN_LD
    if (keep) *(f32x4*)stp = S;
}

#define XB_TMO      128
#define XB_XCNT(j)  (256  + 64 * (j))
#define XB_XSUB(j)  (1280 + 64 * (j))
#define XB_XGEN(j)  (2304 + 64 * (j))
#define XB_TOP      3328
#define XB_TOPGEN   3392
#define XCD_BAR_WORDS 3456
#define XB_SPIN_CAP (1u << 18)

__device__ __forceinline__ unsigned xb_ld(unsigned* p)              { return __hip_atomic_load(p, __ATOMIC_RELAXED, __HIP_MEMORY_SCOPE_AGENT); }
__device__ __forceinline__ unsigned xb_add(unsigned* p, unsigned v) { return __hip_atomic_fetch_add(p, v, __ATOMIC_RELAXED, __HIP_MEMORY_SCOPE_AGENT); }
__device__ __forceinline__ unsigned xb_xcc_id() { return (unsigned)__builtin_amdgcn_s_getreg((3 << 11) | 20) & 0xFu; }
#define XB_SPIN(cond, bar) do { unsigned _sp = 0; while (cond) { __builtin_amdgcn_s_sleep(1); \
    if ((++_sp & 255u) == 0u) { if (xb_ld(&(bar)[XB_TMO])) break; if (_sp > XB_SPIN_CAP) { atomicAdd(&(bar)[XB_TMO], 1u); break; } } } } while (0)

struct XcdBarrier {
    unsigned* bar; unsigned x;
    volatile LAS unsigned* st;
};

__device__ __forceinline__ XcdBarrier xcd_barrier_post(unsigned* bar, volatile LAS unsigned* st) {
    XcdBarrier b; b.bar = bar; b.x = xb_xcc_id(); b.st = st;
    if (threadIdx.x == 0) (void)xb_add(&bar[XB_XCNT(b.x)], 1u);
    return b;
}
__device__ __forceinline__ void xcd_barrier_complete(unsigned* bar, unsigned x, unsigned& nloc, unsigned& nx) {
    const unsigned G = gridDim.x * gridDim.y * gridDim.z;
    unsigned sum, cnt, mine, sp = 0u;
    for (;;) {
        sum = 0u; cnt = 0u; mine = 0u;
#pragma unroll
        for (unsigned j = 0; j < 16; ++j) { const unsigned c = xb_ld(&bar[XB_XCNT(j)]); sum += c; cnt += (c > 0u) ? 1u : 0u; mine = (j == x) ? c : mine; }
        if (sum == G) break;
        __builtin_amdgcn_s_sleep(1);
        if ((++sp & 255u) == 0u) { if (xb_ld(&bar[XB_TMO])) break; if (sp > XB_SPIN_CAP) { atomicAdd(&bar[XB_TMO], 1u); break; } }
    }
    nloc = mine > 0u ? mine : 1u; nx = cnt > 0u ? cnt : 1u;
}

__device__ __forceinline__ void xcd_barrier(const XcdBarrier& b) {
    asm volatile("s_waitcnt vmcnt(0)" ::: "memory");
    __syncthreads();
    if (threadIdx.x == 0) {
        unsigned* bar = b.bar;
        __builtin_amdgcn_s_waitcnt(0);
        unsigned nloc = b.st[0], nx = b.st[1];
        if (nloc == 0u) { xcd_barrier_complete(bar, b.x, nloc, nx); b.st[0] = nloc; b.st[1] = nx; }
        const unsigned old = xb_add(&bar[XB_XSUB(b.x)], 1u);
        const unsigned gen = old / nloc;
        if (old + 1u == (gen + 1u) * nloc) {
            __builtin_amdgcn_fence(__ATOMIC_RELEASE, "agent");
            asm volatile("s_waitcnt vmcnt(0)" ::: "memory");
            const unsigned og = xb_add(&bar[XB_TOP], 1u);
            const unsigned tg = og / nx;
            if (og + 1u == (tg + 1u) * nx) xb_add(&bar[XB_TOPGEN], 1u);
            else XB_SPIN(xb_ld(&bar[XB_TOPGEN]) == tg, bar);
            __builtin_amdgcn_fence(__ATOMIC_ACQUIRE, "agent");
            xb_add(&bar[XB_XGEN(b.x)], 1u);
            asm volatile("s_waitcnt vmcnt(0)" ::: "memory");
        } else {
            XB_SPIN(xb_ld(&bar[XB_XGEN(b.x)]) == gen, bar);
            __builtin_amdgcn_fence(__ATOMIC_ACQUIRE, "agent");
            asm volatile("s_waitcnt vmcnt(0)" ::: "memory");
        }
    }
    __syncthreads();
}

struct Args { const float* in[30]; float* out; unsigned char* ws; int ph_lo, ph_hi; };
enum { I_X = 0, I_P, I_F1GU, I_F1D, I_LN1G, I_LN1B, I_WIN, I_RGNG, I_RGNB, I_MU, I_W0, I_WUP, I_A0, I_AUP, I_GUP, I_KK, I_KA, I_RK, I_WGNG, I_WGNB, I_WOUT, I_LN2G, I_LN2B,
       I_F2GU, I_F2D, I_LN3G, I_LN3B, I_PPROJ, I_PGATE, I_PBIAS };

#define CAS __attribute__((address_space(4)))
#define PHASE_BEGIN(k) if (ph_lo <= (k) && (k) < ph_hi) { \
        int tid_ = threadIdx.x; asm volatile("" : "+v"(tid_)); \
        Ctx c; c.lds = (LAS unsigned char*)lds_raw; c.tid = tid_; c.lane = c.tid & 63; c.wave = __builtin_amdgcn_readfirstlane(c.tid >> 6); \
        c.bx = blockIdx.x; c.G = gridDim.x; c.gw = c.bx * 8 + c.wave; c.NGW = c.G * 8; c.gtid = c.bx * 512 + c.tid; c.NGT = c.G * 512; \
        const CAS Args* ap = (const CAS Args*)__builtin_amdgcn_kernarg_segment_ptr(); asm volatile("" : "+s"(ap)); const CAS Args& a = *ap; unsigned char* ws = a.ws; (void)ws;
#define PHASE_END(k) if ((k) + 1 < ph_hi) xcd_barrier(bar); }
#define P_(T, name, off) T* name = (T*)(ws + (off))

#define GEMM_GU(Aptr, statp, c1p, c2p) do { P_(bf16_t, Wgu_t, WS_WGU); P_(bf16_t, H, WS_A); \
        pg8::Gemm g{Aptr, Wgu_t, M, NGU, D}; pg8::StaticOrder S; S.init(M, NGU, c.G, c.bx); EpiGU E{H, statp, c1p, c2p}; \
        pg8::gemm_phase<EpiGU, pg8::StaticOrder, PG_ALIGN, true>(c.lds, g, S, E, c.tid); } while (0)
#define GEMM_RES(Aptr, Wptr, Kdim, Xraw, Yio, YBp, stat_out, ln_stat, lng, lnb, scale) do { \
        pg8::Gemm g{Aptr, Wptr, M, D, Kdim}; pg8::StaticOrder S; S.init(M, D, c.G, c.bx); EpiRes E{Xraw, Yio, YBp, stat_out, ln_stat, lng, lnb, scale}; \
        pg8::gemm_phase<EpiRes, pg8::StaticOrder, PG_ALIGN, true>(c.lds, g, S, E, c.tid); } while (0)
DI void ln_tail(const Ctx& c, int inst, const float* Y, const float* g, const float* b, float* XF, bf16_t* XB, unsigned* cnt_base) {
    pg8::StaticOrder S; S.init(M, D, c.G, c.bx); pg8::Unit u;
    if (!S.next(0, u)) return;
    unsigned* cnt = cnt_base + inst * 64 + u.pm;
    asm volatile("s_waitcnt vmcnt(0)" ::: "memory");
    __syncthreads();
    if (c.tid == 0) {
        __builtin_amdgcn_fence(__ATOMIC_RELEASE, "agent");
        asm volatile("s_waitcnt vmcnt(0)" ::: "memory");
        __hip_atomic_fetch_add(cnt, 1u, __ATOMIC_RELAXED, __HIP_MEMORY_SCOPE_AGENT);
        unsigned sp = 0;
        while (__hip_atomic_load(cnt, __ATOMIC_RELAXED, __HIP_MEMORY_SCOPE_AGENT) < 4u) { __builtin_amdgcn_s_sleep(1); if (++sp > (1u << 22)) break; }
        __builtin_amdgcn_fence(__ATOMIC_ACQUIRE, "agent");
        asm volatile("s_waitcnt vmcnt(0)" ::: "memory");
    }
    __syncthreads();
    const int lane = c.lane;
    const f32x4 g0 = ((const f32x4*)g)[lane], g1 = ((const f32x4*)g)[lane + 64], g2 = ((const f32x4*)g)[lane + 128], g3 = ((const f32x4*)g)[lane + 192];
    const f32x4 b0 = ((const f32x4*)b)[lane], b1 = ((const f32x4*)b)[lane + 64], b2 = ((const f32x4*)b)[lane + 128], b3 = ((const f32x4*)b)[lane + 192];
    for (int rr = c.wave; rr < 64; rr += 8) {
        const int m = u.pm * 256 + u.pn * 64 + rr;
        const f32x4* yr = (const f32x4*)(Y + (size_t)m * D) + lane;
        f32x4 v0 = yr[0], v1 = yr[64], v2 = yr[128], v3 = yr[192];
        float sm = (v0[0] + v0[1] + v0[2] + v0[3]) + (v1[0] + v1[1] + v1[2] + v1[3]) + (v2[0] + v2[1] + v2[2] + v2[3]) + (v3[0] + v3[1] + v3[2] + v3[3]);
        const float mean = wave_sum(sm) * (1.0f / D);
        v0 = v0 - mean; v1 = v1 - mean; v2 = v2 - mean; v3 = v3 - mean;
        float q = (v0[0] * v0[0] + v0[1] * v0[1] + v0[2] * v0[2] + v0[3] * v0[3]) + (v1[0] * v1[0] + v1[1] * v1[1] + v1[2] * v1[2] + v1[3] * v1[3])
                + (v2[0] * v2[0] + v2[1] * v2[1] + v2[2] * v2[2] + v2[3] * v2[3]) + (v3[0] * v3[0] + v3[1] * v3[1] + v3[2] * v3[2] + v3[3] * v3[3]);
        const float rstd = 1.0f / sqrtf(wave_sum(q) * (1.0f / D) + 1e-5f);
        v0 = v0 * rstd * g0 + b0; v1 = v1 * rstd * g1 + b1; v2 = v2 * rstd * g2 + b2; v3 = v3 * rstd * g3 + b3;
        f32x4* xo = (f32x4*)(XF + (size_t)m * D) + lane; xo[0] = v0; xo[64] = v1; xo[128] = v2; xo[192] = v3;
        u32x2* bo = (u32x2*)(XB + (size_t)m * D) + lane; u32x2 o;
        o.x = cvt_pk_bf16(v0[0], v0[1]); o.y = cvt_pk_bf16(v0[2], v0[3]); bo[0] = o;
        o.x = cvt_pk_bf16(v1[0], v1[1]); o.y = cvt_pk_bf16(v1[2], v1[3]); bo[64] = o;
        o.x = cvt_pk_bf16(v2[0], v2[1]); o.y = cvt_pk_bf16(v2[2], v2[3]); bo[128] = o;
        o.x = cvt_pk_bf16(v3[0], v3[1]); o.y = cvt_pk_bf16(v3[2], v3[3]); bo[192] = o;
    }
}
#define LN_TAIL(inst, gi) do { P_(float, Yt, WS_B); P_(bf16_t, XBt, WS_XB); ln_tail(c, inst, Yt, a.in[gi], a.in[(gi) + 1], a.out, XBt, (unsigned*)(ws + 14336)); } while (0)
#define LN_ROWS(gi) do { P_(float, Y, WS_B); P_(bf16_t, XB, WS_XB); layer_norm_rows(c, Y, a.in[gi], a.in[(gi) + 1], a.out, XB); if (DUP_MISC > 1) layer_norm_rows(c, Y, a.in[gi], a.in[(gi) + 1], a.out, XB); } while (0)

__global__ void __launch_bounds__(512, 2) mk_fwd(Args a_kernarg) {
    extern __shared__ __attribute__((aligned(16))) unsigned char lds_raw[];
    cg::grid_group grid = cg::this_grid();
    const int ph_lo = ((const CAS Args*)__builtin_amdgcn_kernarg_segment_ptr())->ph_lo, ph_hi = ((const CAS Args*)__builtin_amdgcn_kernarg_segment_ptr())->ph_hi;
    if (threadIdx.x < 32) ((volatile LAS unsigned*)((LAS unsigned char*)lds_raw + 135 * 1024))[threadIdx.x] = 0u;
    __syncthreads();
    XcdBarrier bar; bar.bar = nullptr; bar.x = 0; bar.st = nullptr;
    if (ph_hi - ph_lo > 1) bar = xcd_barrier_post((unsigned*)((const CAS Args*)__builtin_amdgcn_kernarg_segment_ptr())->ws, (volatile LAS unsigned*)((LAS unsigned char*)lds_raw + 135 * 1024));
    if (ph_hi > NPH) grid.sync();
    constexpr int PH_ROUND0 = 8, PH_WOUT = 8 + NR + 2;

    PHASE_BEGIN(0)
        P_(bf16_t, Wgu_t, WS_WGU); P_(bf16_t, Wd_t, WS_WD); P_(bf16_t, XB, WS_XB);
        { LAS float* scr0 = (LAS float*)(c.lds + c.wave * 8448);
          for (int it = c.gw; it < 2816; it += c.NGW) { const int kb = it / 176, nb = it % 176; transpose_item(a.in[I_F1GU], NGU, Wgu_t, D, gu_dst_row(32 * nb), 64 * kb, 32 * nb, scr0, c.lane); } }
        for (int i = c.gtid; i < (int)((WS_ZERO_BYTES - WS_C1WIN) / 16); i += c.NGT) ((u32x4*)(ws + WS_C1WIN))[i] = (u32x4){0u, 0u, 0u, 0u};
        cvt_rows_bf16(c, a.in[I_X], XB, (size_t)M * D / 4);
    PHASE_END(0)
#define RSTAT(i) ((float*)(ws + WS_RSTAT) + (size_t)(i) * 2 * M)
    PHASE_BEGIN(1) {
        { P_(bf16_t, XB, WS_XB); GEMM_GU(XB, (const float*)nullptr, (const float*)nullptr, (const float*)nullptr); }
        if (c.bx >= c.G / 2) {
            P_(bf16_t, Win_t, WS_WIN); P_(bf16_t, Wlora_t, WS_WLORA); P_(bf16_t, Wout_t, WS_WOUT); P_(float, CS, WS_CS);
            const int gw2 = (c.bx - c.G / 2) * 8 + c.wave, ngw2 = (c.G / 2) * 8, gt2 = (c.bx - c.G / 2) * 512 + c.tid, ngt2 = (c.G / 2) * 512;
            LAS float* scr = (LAS float*)(c.lds + c.wave * 8448);
            { P_(bf16_t, Wd_t, WS_WD); for (int it = gw2; it < 1408; it += ngw2) { const int kb = it / 32, nb = it % 32; transpose_item(a.in[I_F1D], D, Wd_t, FF, 32 * nb, 64 * kb, 32 * nb, scr, c.lane); } }
            for (int it = gw2; it < 1936 + 512; it += ngw2) {
                if (it < 1936) { const int kb = it / 121, nb = it % 121; transpose_item(a.in[I_WIN], NIN, Win_t, D, win_dst_row(32 * nb), 64 * kb, 32 * nb, scr, c.lane, a.in[I_LN1G], a.in[I_LN1B], (float*)(ws + WS_C1WIN), (float*)(ws + WS_C2WIN)); }
                else { const int r = it - 1936, kb = r / 32, nb = r % 32; transpose_item(a.in[I_WOUT], D, Wout_t, D, 32 * nb, 64 * kb, 32 * nb, scr, c.lane); }
            }
            for (int i = gt2; i < (NINP - NIN) * D / 8; i += ngt2) ((u32x4*)(Win_t + (size_t)NIN * D))[i] = (u32x4){0u, 0u, 0u, 0u};
            for (int i = gt2; i < NL * (KL / 8); i += ngt2) {
                const int kg = i / NL, n = i % NL, k0 = 8 * kg; u32x4 o = (u32x4){0u, 0u, 0u, 0u};
                const float* src = nullptr;
                if (n < 512) { if (k0 < 64) src = a.in[I_WUP] + (size_t)k0 * 512 + n; }
                else if (n < 1024) { if (k0 >= 64 && k0 < 128) src = a.in[I_AUP] + (size_t)(k0 - 64) * 512 + (n - 512); }
                else { if (k0 >= 128 && k0 < 288) src = a.in[I_GUP] + (size_t)(k0 - 128) * 512 + (n - 1024); }
                if (src) { o.x = cvt_pk_bf16(src[0], src[512]); o.y = cvt_pk_bf16(src[1024], src[1536]); o.z = cvt_pk_bf16(src[2048], src[2560]); o.w = cvt_pk_bf16(src[3072], src[3584]); }
                *(u32x4*)(Wlora_t + (size_t)n * KL + k0) = o;
            }
            for (int i = gt2; i < SEQ * 32; i += ngt2) {
                const int pos = i >> 5, f = i & 31; double pw = 1.0; for (int j = 0; j < f; ++j) pw *= 0.7498942093324559;
                const float invf = (float)pw; const float ang = (float)pos * invf;
                double r = (double)ang; r -= 6.283185307179586 * __builtin_rint(r * 0.15915494309189535); const double x = r * 0.25, x2 = x * x;
                double sn = x * (1.0 + x2 * (-1.0 / 6 + x2 * (1.0 / 120 + x2 * (-1.0 / 5040 + x2 * (1.0 / 362880 + x2 * (-1.0 / 39916800 + x2 * (1.0 / 6227020800.0)))))));
                double cn = 1.0 + x2 * (-0.5 + x2 * (1.0 / 24 + x2 * (-1.0 / 720 + x2 * (1.0 / 40320 + x2 * (-1.0 / 3628800 + x2 * (1.0 / 479001600.0 + x2 * (-1.0 / 87178291200.0)))))));
                double s2 = 2.0 * sn * cn, c2 = 1.0 - 2.0 * sn * sn; sn = 2.0 * s2 * c2; cn = 1.0 - 2.0 * s2 * s2;
                CS[2 * i] = (float)cn; CS[2 * i + 1] = (float)sn;
            }
        }
    } PHASE_END(1)
    PHASE_BEGIN(2) { P_(bf16_t, H, WS_A); P_(bf16_t, Wd_t, WS_WD); P_(bf16_t, XB, WS_XB);
        GEMM_RES(H, Wd_t, FF, a.in[I_X], a.out, XB, RSTAT(0), (const float*)nullptr, (const float*)nullptr, (const float*)nullptr, 0.5f); } PHASE_END(2)
    PHASE_BEGIN(3) {
        P_(bf16_t, XB, WS_XB); P_(bf16_t, Win_t, WS_WIN); P_(bf16_t, ZRET, WS_A); P_(bf16_t, ZRW, WS_B); P_(float, CS, WS_CS);
        pg8::Gemm g{XB, Win_t, M, NINP, D}; pg8::StaticOrder S; S.init(M, NINP, c.G, c.bx); EpiWin E{ZRET, ZRW, CS, RSTAT(0), (const float*)(ws + WS_C1WIN), (const float*)(ws + WS_C2WIN)};
        pg8::gemm_phase<EpiWin, pg8::StaticOrder, PG_ALIGN, true>(c.lds, g, S, E, c.tid);
    } PHASE_END(3)
    PHASE_BEGIN(4) {
        P_(bf16_t, ZRET, WS_A); P_(bf16_t, ZRW, WS_B); P_(bf16_t, LA, WS_A + 64 * MiB); P_(bf16_t, MIX, WS_XB);
        prep_lora_a(c, ZRW, a.in[I_MU], LA);
#ifdef DUP_PREPA
        prep_lora_a(c, ZRW, a.in[I_MU], LA);
#endif
        { P_(float, KV, WS_SC); ret_kv(c, ZRET, KV); }
    } PHASE_END(4)
    PHASE_BEGIN(5) { P_(float, KV, WS_SC); P_(bf16_t, PS, WS_PB); ret_prefix(c, KV, PS); } PHASE_END(5)
    PHASE_BEGIN(6) { P_(bf16_t, ZRET, WS_A); P_(bf16_t, PS, WS_PB); P_(bf16_t, MIXr, WS_XB); ret_out(c, ZRET, PS, a.in[I_RGNG], a.in[I_RGNB], MIXr); } PHASE_END(6)
    PHASE_BEGIN(7) {
        P_(bf16_t, LA, WS_A + 64 * MiB); P_(bf16_t, Wlora_t, WS_WLORA); P_(float, LW, WS_A); P_(bf16_t, LA2, WS_A + 32 * MiB); P_(bf16_t, LG, WS_A + 48 * MiB);
        int kdim = KL; asm volatile("" : "+s"(kdim)); pg8::Gemm g{LA, Wlora_t, M, NL, kdim}; pg8::StaticOrder S; S.init(M, NL, c.G, c.bx); EpiLora E{LW, LA2, LG, a.in[I_W0], a.in[I_A0]};
        pg8::gemm_phase<EpiLora, pg8::StaticOrder, PG_ALIGN, true>(c.lds, g, S, E, c.tid);
#if DUP_GEMM > 1
        __syncthreads(); pg8::gemm_phase<EpiLora, pg8::StaticOrder, PG_ALIGN, true>(c.lds, g, S, E, c.tid);
#endif
    } PHASE_END(7)
    for (int p = 0; p < NR + 2; ++p) {
        PHASE_BEGIN(PH_ROUND0 + p) {
            P_(float, ST, WS_ST); P_(float, YBA, WS_PB);
            float* SCb[2] = {(float*)(ws + WS_SC), (float*)(ws + WS_A + 64 * MiB)};
            float* SCw = (p & 1) ? SCb[1] : SCb[0]; float* SCr = (p & 1) ? SCb[0] : SCb[1];
            float* YBw = YBA + (size_t)((p & 1) ^ 1) * (32 * TR * 64); float* YBr = YBA + (size_t)(p & 1) * (32 * TR * 64);
            volatile LAS unsigned* ctl = (volatile LAS unsigned*)(c.lds + 135 * 1024 + 64);
            if ((p == 0 || p == NR + 1) && (c.wave == 0 || c.wave == 2 || c.wave == 5)) {
                P_(bf16_t, Wgu_t, WS_WGU); P_(bf16_t, Wd_t, WS_WD);
                LAS float* scr = (LAS float*)(c.lds + c.wave * 8448);
                const int widx = c.bx * 3 + (c.wave == 0 ? 0 : (c.wave == 2 ? 1 : 2)), lo_it = p == 0 ? 0 : 2112, hi_it = p == 0 ? 2112 : 4224;
                for (int it = lo_it + widx; it < hi_it; it += c.G * 3) {
                    if (it < 2816) { const int kb = it / 176, nb = it % 176; transpose_item(a.in[I_F2GU], NGU, Wgu_t, D, gu_dst_row(32 * nb), 64 * kb, 32 * nb, scr, c.lane, a.in[I_LN2G], a.in[I_LN2B], (float*)(ws + WS_C1GU), (float*)(ws + WS_C2GU)); }
                    else { const int r = it - 2816, kb = r / 32, nb = r % 32; transpose_item(a.in[I_F2D], D, Wd_t, FF, 32 * nb, 64 * kb, 32 * nb, scr, c.lane); }
                }
            } else if (c.wave == 0 || c.wave == 5) {
#ifdef DUP_SCAN
                if (p >= 1 && p <= NR) scan_round(c, c.wave ? 1 : 0, p - 1, YBw, ST, ctl, false);
#endif
                __builtin_amdgcn_s_setprio(3);
                if (p >= 1 && p <= NR) scan_round(c, c.wave ? 1 : 0, p - 1, YBw, ST, ctl);
                __builtin_amdgcn_s_setprio(0);
            } else if (c.wave == 2) {
                if (p >= 1 && p <= NR) scan_loader(c, p - 1, SCr, ctl);
            } else {
                P_(bf16_t, ZRW, WS_B); P_(float, LW, WS_A); P_(bf16_t, LA2, WS_A + 32 * MiB); P_(bf16_t, LG, WS_A + 48 * MiB); P_(bf16_t, MIX, WS_XB);
                const int sidx = c.wave == 1 ? 0 : (c.wave == 3 ? 1 : (c.wave == 4 ? 2 : c.wave - 3));
                const int lw = (c.bx >> 3) * 5 + sidx;
                const int sbh = (c.bx & 7) * 4 + (lw & 3), tl_first = lw >> 2, tstep = (c.G >> 3) * 5 / 4;
                SideP SP{ZRW, LW, LA2, LG, a.in[I_MU], a.in[I_KK], a.in[I_KA], a.in[I_RK], a.in[I_WGNG], a.in[I_WGNB], MIX};
                rounds_side(sbh, tl_first, tstep, c.lane, p, SP, SCw, YBr);
            }
        } PHASE_END(PH_ROUND0 + p)
    }
    PHASE_BEGIN(PH_WOUT) {
        { P_(bf16_t, MIX, WS_XB); P_(bf16_t, Wout_t, WS_WOUT); P_(bf16_t, YB2, WS_B);
          GEMM_RES(MIX, Wout_t, D, (const float*)nullptr, a.out, YB2, RSTAT(1), (const float*)RSTAT(0), a.in[I_LN1G], a.in[I_LN1B], 1.0f); }
        { P_(bf16_t, Wpp_t, WS_WPP); P_(bf16_t, PB, WS_PB); LAS float* scr = (LAS float*)(c.lds + c.wave * 8448);
          for (int it = c.gw; it < 128; it += c.NGW) { const int kb = it / 32, nb = it % 32; transpose_item(a.in[I_PPROJ], D, Wpp_t, DP, 32 * nb, 64 * kb, 32 * nb, scr, c.lane); }
          cvt_rows_bf16(c, a.in[I_P], PB, (size_t)M * DP / 4); }
    } PHASE_END(PH_WOUT)
    PHASE_BEGIN(PH_WOUT + 1) {
        { P_(bf16_t, YB2, WS_B); GEMM_GU(YB2, (const float*)RSTAT(1), (const float*)(ws + WS_C1GU), (const float*)(ws + WS_C2GU)); }
        if (c.bx >= c.G / 2) {
            P_(bf16_t, Wpg_t, WS_WPG); P_(bf16_t, Wpp_t, WS_WPP); P_(bf16_t, PB, WS_PB); P_(bf16_t, PROJ, WS_XB);
            const int gw2 = (c.bx - c.G / 2) * 8 + c.wave, ngw2 = (c.G / 2) * 8;
            LAS float* scr = (LAS float*)(c.lds + c.wave * 8448);
            for (int it = gw2; it < 512; it += ngw2) { const int kb = it / 32, nb = it % 32; transpose_item(a.in[I_PGATE], D, Wpg_t, D, 32 * nb, 64 * kb, 32 * nb, scr, c.lane, a.in[I_LN3G], a.in[I_LN3B], (float*)(ws + WS_C1PG), (float*)(ws + WS_C2PG)); }
            __syncthreads();
            { int kdim = DP; asm volatile("" : "+s"(kdim)); const int t3 = launder_v(c.tid); pg8::Gemm g{PB, Wpp_t, M, D, kdim}; pg8::StaticOrder S; S.init(M, D, c.G / 2, c.bx - c.G / 2); EpiProj E{PROJ};
              pg8::gemm_phase<EpiProj, pg8::StaticOrder, PG_ALIGN, true>(c.lds, g, S, E, t3); }
        }
    } PHASE_END(PH_WOUT + 1)
    PHASE_BEGIN(PH_WOUT + 2) { P_(bf16_t, H, WS_A); P_(bf16_t, Wd_t, WS_WD); P_(bf16_t, YB3, WS_B);
        GEMM_RES(H, Wd_t, FF, (const float*)nullptr, a.out, YB3, RSTAT(2), (const float*)RSTAT(1), a.in[I_LN2G], a.in[I_LN2B], 0.5f); } PHASE_END(PH_WOUT + 2)
    PHASE_BEGIN(PH_WOUT + 3) {
        P_(bf16_t, YB3, WS_B); P_(bf16_t, Wpg_t, WS_WPG); P_(bf16_t, PROJ, WS_XB);
        { pg8::Gemm g{YB3, Wpg_t, M, D, D}; pg8::StaticOrder S; S.init(M, D, c.G, c.bx);
          EpiGate E{a.out, PROJ, a.in[I_PBIAS], RSTAT(2), (const float*)(ws + WS_C1PG), (const float*)(ws + WS_C2PG), a.in[I_LN3G], a.in[I_LN3B]};
          pg8::gemm_phase<EpiGate, pg8::StaticOrder, PG_ALIGN, true>(c.lds, g, S, E, c.tid); }
    } PHASE_END(PH_WOUT + 3)
}

#ifndef MK_SPLIT
#define MK_SPLIT 0
#endif
extern "C" void kernel_launch(void* const* d_in, const int* in_sizes, int n_in, void* d_out, int out_size, void* d_ws, size_t ws_size, hipStream_t stream) {
    static int ready = 0;
    if (!ready) {
        if (n_in != 30 || out_size != M * D || ws_size < WS_END) { fprintf(stderr, "kernel_launch: unexpected problem (n_in %d out %d ws %zu)\n", n_in, out_size, ws_size); ready = -1; return; }
        if (hipFuncSetAttribute((const void*)mk_fwd, hipFuncAttributeMaxDynamicSharedMemorySize, LDS_BYTES) != hipSuccess) { fprintf(stderr, "kernel_launch: hipFuncSetAttribute failed\n"); ready = -1; return; }
        int per_cu = 0; (void)hipOccupancyMaxActiveBlocksPerMultiprocessor(&per_cu, (const void*)mk_fwd, 512, LDS_BYTES); (void)hipGetLastError();
        ready = 1;
    }
    if (ready < 0) return;
    if (hipMemsetAsync(d_ws, 0, 16384, stream) != hipSuccess) { fprintf(stderr, "kernel_launch: memset failed\n"); return; }
    Args a{};
    for (int i = 0; i < 30; ++i) a.in[i] = (const float*)d_in[i];
    a.out = (float*)d_out; a.ws = (unsigned char*)d_ws;
#if MK_SPLIT
    for (int ph = 0; ph < NPH; ++ph) { a.ph_lo = ph; a.ph_hi = ph + 1; hipLaunchKernelGGL(mk_fwd, dim3(256), dim3(512), LDS_BYTES, stream, a); }
#else
    a.ph_lo = 0; a.ph_hi = NPH;
    void* args[] = {&a};
    hipError_t e = hipLaunchCooperativeKernel((const void*)mk_fwd, dim3(256), dim3(512), args, LDS_BYTES, stream);
    if (e != hipSuccess) fprintf(stderr, "kernel_launch: cooperative launch failed: %s\n", hipGetErrorString(e));
#endif
}
```
